# Optimizing an MI355X kernel written in HIP

```python
import math
import jax, jax.numpy as jnp
from jax import lax
import numpy as np

D_MODEL = 1024
BATCH = 8
SEQ = 2048
DEPTH = 4

HEAD_DIM = 64
MIX_WIDTH = D_MODEL
SSM_WIDTH = 3 * D_MODEL // 8
SSM_GROUP_CH = 16
SSM_GROUPS = SSM_WIDTH // SSM_GROUP_CH
SSM_STATE = 64
DIL_WIDTH = 3 * D_MODEL // 8
DIL_HEADS = DIL_WIDTH // HEAD_DIM
DIL_PATTERNS = ((128, 1), (512, 4), (2048, 16))
DIFF_WIDTH = MIX_WIDTH - SSM_WIDTH - DIL_WIDTH
DIFF_HEADS = DIFF_WIDTH // HEAD_DIM
DIFF_QK_DIM = HEAD_DIM // 2
IN_WIDTH = SSM_WIDTH + 3 * DIL_WIDTH + 3 * DIFF_WIDTH
Q_BLOCK = 128
PEER_HEADS = 8
PEER_KEYS = 128
PEER_EXPERTS = PEER_KEYS * PEER_KEYS
PEER_TOPK = 16
PEER_QUERY_DIM = 256
PEER_HALF = PEER_QUERY_DIM // 2
PEER_TOKEN_BLOCK = 128
NORM_EPS = 1e-6

kernel_name = "hybrid_s5_dilated_diffattn_peer"


def rms_norm(x, gain):
    xf = x.astype(jnp.float32)
    y = xf * lax.rsqrt(jnp.mean(xf * xf, axis=-1, keepdims=True) + NORM_EPS)
    return (y * gain.astype(jnp.float32)).astype(x.dtype)


def _linear_recurrence_combine(left, right):
    a_l, b_l = left
    a_r, b_r = right
    return a_r * a_l, a_r * b_l + b_r


def s5_mixer(u, lam_re, lam_im, log_step, b_re, b_im, c_re, c_im, d_skip):
    f32 = jnp.float32
    bsz, seq, _ = u.shape
    uf = u.astype(f32).reshape(bsz, seq, SSM_GROUPS, SSM_GROUP_CH)
    lam = lax.complex(lam_re.astype(f32), lam_im.astype(f32))
    step = jnp.exp(log_step.astype(f32))[:, None]
    lam_bar = jnp.exp(lam * step)
    b_mat = lax.complex(b_re.astype(f32), b_im.astype(f32))
    b_bar = ((lam_bar - 1.0) / lam)[:, :, None] * b_mat
    bu = jnp.einsum("gpc,blgc->blgp", b_bar, uf.astype(jnp.complex64))
    decay = jnp.broadcast_to(lam_bar, bu.shape)
    _, states = lax.associative_scan(_linear_recurrence_combine, (decay, bu), axis=1)
    c_mat = lax.complex(c_re.astype(f32), c_im.astype(f32))
    y = jnp.real(jnp.einsum("gcp,blgp->blgc", c_mat, states))
    y = y + d_skip.astype(f32).reshape(SSM_GROUPS, SSM_GROUP_CH) * uf
    return y.reshape(bsz, seq, SSM_WIDTH)


def dilated_attention(q, k, v):
    f32 = jnp.float32
    bsz, seq, _ = q.shape
    q = q.reshape(bsz, seq, DIL_HEADS, HEAD_DIM).transpose(0, 2, 1, 3)
    k = k.reshape(bsz, seq, DIL_HEADS, HEAD_DIM).transpose(0, 2, 1, 3)
    v = v.reshape(bsz, seq, DIL_HEADS, HEAD_DIM).transpose(0, 2, 1, 3)
    n_blk = seq // Q_BLOCK
    q_blocks = q.reshape(bsz, DIL_HEADS, n_blk, Q_BLOCK, HEAD_DIM).transpose(2, 0, 1, 3, 4)
    scale = HEAD_DIM ** -0.5

    def one_block(args):
        qb, blk = args
        pos = blk * Q_BLOCK + jnp.arange(Q_BLOCK)
        outs, lses = [], []
        for window, dil in DIL_PATTERNS:
            offs = dil * jnp.arange(window // dil + 1)
            idx = pos[:, None] - offs[None, :]
            valid = idx >= 0
            idx = jnp.maximum(idx, 0)
            kg = k[:, :, idx]
            vg = v[:, :, idx]
            s = jnp.einsum("bhqd,bhqjd->bhqj", qb, kg).astype(f32) * scale
            s = jnp.where(valid, s, -jnp.inf)
            m = jnp.max(s, axis=-1, keepdims=True)
            p = jnp.exp(s - m)
            den = jnp.sum(p, axis=-1, keepdims=True)
            outs.append(jnp.einsum("bhqj,bhqjd->bhqd", p / den, vg.astype(f32)))
            lses.append(m[..., 0] + jnp.log(den[..., 0]))
        weights = jax.nn.softmax(jnp.stack(lses), axis=0)
        return jnp.sum(weights[..., None] * jnp.stack(outs), axis=0)

    out = lax.map(one_block, (q_blocks, jnp.arange(n_blk)))
    return out.transpose(1, 0, 3, 2, 4).reshape(bsz, seq, DIL_WIDTH)


def diff_attention(q, k, v, lam_q1, lam_k1, lam_q2, lam_k2, subln_g, lambda_init):
    f32 = jnp.float32
    bsz, seq, _ = q.shape
    q = q.reshape(bsz, seq, DIFF_HEADS, 2, DIFF_QK_DIM).transpose(0, 2, 3, 1, 4)
    k = k.reshape(bsz, seq, DIFF_HEADS, 2, DIFF_QK_DIM).transpose(0, 2, 3, 1, 4)
    v = v.reshape(bsz, seq, DIFF_HEADS, HEAD_DIM).transpose(0, 2, 1, 3).astype(f32)
    lam = (jnp.exp(jnp.sum(lam_q1.astype(f32) * lam_k1.astype(f32)))
           - jnp.exp(jnp.sum(lam_q2.astype(f32) * lam_k2.astype(f32))) + lambda_init)
    n_blk = seq // Q_BLOCK
    q_blocks = q.reshape(bsz, DIFF_HEADS, 2, n_blk, Q_BLOCK, DIFF_QK_DIM).transpose(3, 0, 1, 2, 4, 5)
    key_pos = jnp.arange(seq)
    scale = DIFF_QK_DIM ** -0.5

    def one_block(args):
        qb, blk = args
        pos = blk * Q_BLOCK + jnp.arange(Q_BLOCK)
        s = jnp.einsum("bhmqd,bhmkd->bhmqk", qb, k).astype(f32) * scale
        s = jnp.where(key_pos[None, :] <= pos[:, None], s, -jnp.inf)
        p = jax.nn.softmax(s, axis=-1)
        attn = p[:, :, 0] - lam * p[:, :, 1]
        return jnp.einsum("bhqk,bhkd->bhqd", attn, v)

    out = lax.map(one_block, (q_blocks, jnp.arange(n_blk)))
    out = out.transpose(1, 0, 3, 2, 4)
    out = rms_norm(out, subln_g) * (1.0 - lambda_init)
    return out.reshape(bsz, seq, DIFF_WIDTH)


def hybrid_mixer(h, w_in, lam_re, lam_im, log_step, b_re, b_im, c_re, c_im, d_skip,
                 w_glu, ssm_norm_g, dil_norm_g, lam_q1, lam_k1, lam_q2, lam_k2, subln_g,
                 w_out, lambda_init):
    proj = h @ w_in
    cuts = [SSM_WIDTH,
            SSM_WIDTH + DIL_WIDTH,
            SSM_WIDTH + 2 * DIL_WIDTH,
            SSM_WIDTH + 3 * DIL_WIDTH,
            SSM_WIDTH + 3 * DIL_WIDTH + DIFF_WIDTH,
            SSM_WIDTH + 3 * DIL_WIDTH + 2 * DIFF_WIDTH]
    u_ssm, dq, dk, dv, fq, fk, fv = jnp.split(proj, cuts, axis=-1)
    y = s5_mixer(u_ssm, lam_re, lam_im, log_step, b_re, b_im, c_re, c_im, d_skip)
    g = jax.nn.gelu(y)
    y = g * jax.nn.sigmoid(g @ w_glu.astype(jnp.float32))
    y_ssm = rms_norm(y, ssm_norm_g).astype(h.dtype)
    y_dil = rms_norm(dilated_attention(dq, dk, dv), dil_norm_g).astype(h.dtype)
    y_diff = diff_attention(fq, fk, fv, lam_q1, lam_k1, lam_q2, lam_k2, subln_g,
                            lambda_init).astype(h.dtype)
    return jnp.concatenate([y_ssm, y_dil, y_diff], axis=-1) @ w_out


def peer_ffn(h, w_query, sub_keys, u_exp, v_exp):
    f32 = jnp.float32
    bsz, seq, dm = h.shape
    flat = h.reshape(-1, dm)
    n_chunks = flat.shape[0] // PEER_TOKEN_BLOCK
    chunks = flat.reshape(n_chunks, PEER_TOKEN_BLOCK, dm)

    def one_chunk(xc):
        q = (xc @ w_query).reshape(PEER_TOKEN_BLOCK, PEER_HEADS, 2, PEER_HALF)
        s = jnp.einsum("thcd,hcnd->thcn", q, sub_keys).astype(f32)
        top_s, top_i = lax.top_k(s, PEER_TOPK)
        cand_s = top_s[:, :, 0, :, None] + top_s[:, :, 1, None, :]
        cand_i = top_i[:, :, 0, :, None] * PEER_KEYS + top_i[:, :, 1, None, :]
        cand_s = cand_s.reshape(PEER_TOKEN_BLOCK, PEER_HEADS, PEER_TOPK * PEER_TOPK)
        cand_i = cand_i.reshape(PEER_TOKEN_BLOCK, PEER_HEADS, PEER_TOPK * PEER_TOPK)
        best_s, best_j = lax.top_k(cand_s, PEER_TOPK)
        expert = jnp.take_along_axis(cand_i, best_j, axis=-1)
        gate = jax.nn.softmax(best_s, axis=-1)
        u = u_exp[expert]
        act = jax.nn.gelu(jnp.einsum("thkd,td->thk", u, xc).astype(f32))
        vv = v_exp[expert]
        return jnp.einsum("thk,thkd->td", (gate * act).astype(vv.dtype), vv).astype(xc.dtype)

    out = lax.map(one_chunk, chunks)
    return out.reshape(bsz, seq, dm)


def setup_inputs(seed: int = 0) -> dict:
    key = jax.random.key(seed)
    ks = jax.random.split(key, 26)
    f32 = jnp.float32

    def nrm(k, shape, scale):
        return scale * jax.random.normal(k, shape, f32)

    def gain(k, shape):
        return 1.0 + 0.02 * jax.random.normal(k, shape, f32)

    L = DEPTH
    x = jax.random.normal(ks[0], (BATCH, SEQ, D_MODEL), f32)
    norm1_g = gain(ks[1], (L, D_MODEL))
    w_in = nrm(ks[2], (L, D_MODEL, IN_WIDTH), D_MODEL ** -0.5)
    ssm_lam_re = -0.5 + nrm(ks[3], (L, SSM_GROUPS, SSM_STATE), 0.01)
    ssm_lam_im = jnp.pi * jnp.arange(SSM_STATE, dtype=f32) + nrm(ks[4], (L, SSM_GROUPS, SSM_STATE), 0.01)
    ssm_log_step = jax.random.uniform(ks[5], (L, SSM_GROUPS), f32,
                                      minval=math.log(1e-3), maxval=math.log(1e-1))
    ssm_b_re = nrm(ks[6], (L, SSM_GROUPS, SSM_STATE, SSM_GROUP_CH), (2 * SSM_GROUP_CH) ** -0.5)
    ssm_b_im = nrm(ks[7], (L, SSM_GROUPS, SSM_STATE, SSM_GROUP_CH), (2 * SSM_GROUP_CH) ** -0.5)
    ssm_c_re = nrm(ks[8], (L, SSM_GROUPS, SSM_GROUP_CH, SSM_STATE), SSM_STATE ** -0.5)
    ssm_c_im = nrm(ks[9], (L, SSM_GROUPS, SSM_GROUP_CH, SSM_STATE), SSM_STATE ** -0.5)
    ssm_d = nrm(ks[10], (L, SSM_WIDTH), 1.0)
    ssm_w_glu = nrm(ks[11], (L, SSM_WIDTH, SSM_WIDTH), SSM_WIDTH ** -0.5)
    ssm_norm_g = gain(ks[12], (L, SSM_WIDTH))
    dil_norm_g = gain(ks[13], (L, DIL_WIDTH))
    diff_lam_q1 = nrm(ks[14], (L, DIFF_QK_DIM), 0.1)
    diff_lam_k1 = nrm(ks[15], (L, DIFF_QK_DIM), 0.1)
    diff_lam_q2 = nrm(ks[16], (L, DIFF_QK_DIM), 0.1)
    diff_lam_k2 = nrm(ks[17], (L, DIFF_QK_DIM), 0.1)
    diff_subln_g = gain(ks[18], (L, HEAD_DIM))
    w_out = nrm(ks[19], (L, MIX_WIDTH, D_MODEL), MIX_WIDTH ** -0.5)
    norm2_g = gain(ks[20], (L, D_MODEL))
    peer_w_query = nrm(ks[21], (L, D_MODEL, PEER_HEADS * PEER_QUERY_DIM), D_MODEL ** -0.5)
    peer_sub_keys = nrm(ks[22], (L, PEER_HEADS, 2, PEER_KEYS, PEER_HALF), PEER_HALF ** -0.5)
    peer_u = nrm(ks[23], (L, PEER_EXPERTS, D_MODEL), D_MODEL ** -0.5)
    peer_v = nrm(ks[24], (L, PEER_EXPERTS, D_MODEL), PEER_HEADS ** -0.5)
    final_norm_g = gain(ks[25], (D_MODEL,))
    return {"x": x, "norm1_g": norm1_g, "w_in": w_in,
            "ssm_lam_re": ssm_lam_re, "ssm_lam_im": ssm_lam_im, "ssm_log_step": ssm_log_step,
            "ssm_b_re": ssm_b_re, "ssm_b_im": ssm_b_im, "ssm_c_re": ssm_c_re, "ssm_c_im": ssm_c_im,
            "ssm_d": ssm_d, "ssm_w_glu": ssm_w_glu, "ssm_norm_g": ssm_norm_g, "dil_norm_g": dil_norm_g,
            "diff_lam_q1": diff_lam_q1, "diff_lam_k1": diff_lam_k1, "diff_lam_q2": diff_lam_q2,
            "diff_lam_k2": diff_lam_k2, "diff_subln_g": diff_subln_g, "w_out": w_out,
            "norm2_g": norm2_g, "peer_w_query": peer_w_query, "peer_sub_keys": peer_sub_keys,
            "peer_u": peer_u, "peer_v": peer_v, "final_norm_g": final_norm_g}


def reference(x, norm1_g, w_in, ssm_lam_re, ssm_lam_im, ssm_log_step, ssm_b_re, ssm_b_im,
              ssm_c_re, ssm_c_im, ssm_d, ssm_w_glu, ssm_norm_g, dil_norm_g, diff_lam_q1,
              diff_lam_k1, diff_lam_q2, diff_lam_k2, diff_subln_g, w_out, norm2_g,
              peer_w_query, peer_sub_keys, peer_u, peer_v, final_norm_g):
    for layer in range(DEPTH):
        lambda_init = 0.8 - 0.6 * math.exp(-0.3 * layer)
        h = rms_norm(x, norm1_g[layer])
        x = x + hybrid_mixer(h, w_in[layer], ssm_lam_re[layer], ssm_lam_im[layer],
                             ssm_log_step[layer], ssm_b_re[layer], ssm_b_im[layer],
                             ssm_c_re[layer], ssm_c_im[layer], ssm_d[layer], ssm_w_glu[layer],
                             ssm_norm_g[layer], dil_norm_g[layer], diff_lam_q1[layer],
                             diff_lam_k1[layer], diff_lam_q2[layer], diff_lam_k2[layer],
                             diff_subln_g[layer], w_out[layer], lambda_init)
        h = rms_norm(x, norm2_g[layer])
        x = x + peer_ffn(h, peer_w_query[layer], peer_sub_keys[layer], peer_u[layer], peer_v[layer])
    return rms_norm(x, final_norm_g)
```

```cpp
#include <hip/hip_runtime.h>
#include <cstdint>
#include <cstdio>
#include <cmath>

typedef unsigned short bf16_t;
typedef short bf16x8 __attribute__((ext_vector_type(8)));
typedef float f32x4 __attribute__((ext_vector_type(4)));
typedef unsigned u32x4 __attribute__((ext_vector_type(4)));
typedef unsigned u32x2 __attribute__((ext_vector_type(2)));

constexpr int T = 16384, DM = 1024, NL = 4, SEQ = 2048, NB = 8;
constexpr int INW = 2304;
constexpr int SSMW = 384, DILW = 384, DIFW = 256;
constexpr int NG = 24, GC = 16, NS = 64;
constexpr int DILH = 6, DIFH = 4;
constexpr int PH = 8, PK = 128, PE = 16384, PTOP = 16, PQD = 256, PHALF = 128;
constexpr int OFF_DQ = 384, OFF_DK = 768, OFF_DV = 1152, OFF_FQ = 1536, OFF_FK = 1792, OFF_FV = 2048;
constexpr float EPS = 1e-6f;

__device__ __forceinline__ float bf2f(bf16_t h) { return __uint_as_float(((unsigned)h) << 16); }
__device__ __forceinline__ unsigned pk2(float a, float b) {
    typedef __bf16 bf2 __attribute__((ext_vector_type(2)));
    typedef float f2 __attribute__((ext_vector_type(2)));
    f2 v = {a, b};
    bf2 r = __builtin_convertvector(v, bf2);
    return __builtin_bit_cast(unsigned, r);
}
__device__ __forceinline__ bf16_t f2bf(float a) { return (bf16_t)(pk2(a, 0.f) & 0xffffu); }
__device__ __forceinline__ float lo_bf(unsigned w) { return __uint_as_float(w << 16); }
__device__ __forceinline__ float hi_bf(unsigned w) { return __uint_as_float(w & 0xffff0000u); }
__device__ __forceinline__ float gelu_tanh(float x) {
    const float u = 0.7978845608028654f * (x + 0.044715f * x * x * x);
    return 0.5f * x * (1.0f + tanhf(u));
}
__device__ __forceinline__ float wave_sum(float v) {
#pragma unroll
    for (int o = 32; o >= 1; o >>= 1) v += __shfl_xor(v, o);
    return v;
}

struct WS {
    bf16_t *WinT, *WoutT, *WqT, *WgluT, *SKb, *Ub, *Vb;
    float* xres; bf16_t* xb; float *rs1, *rs2;
    bf16_t *proj, *yssm, *ydil, *cat, *q;
    int* pidx; float* pgate;
};
static size_t ws_carve(unsigned char* base, WS& w) {
    size_t o = 0;
    auto take = [&](size_t bytes) { size_t r = o; o += (bytes + 255) & ~(size_t)255; return base + r; };
    w.WinT = (bf16_t*)take((size_t)NL * INW * DM * 2);
    w.WoutT = (bf16_t*)take((size_t)NL * DM * DM * 2);
    w.WqT = (bf16_t*)take((size_t)NL * 2048 * DM * 2);
    w.WgluT = (bf16_t*)take((size_t)NL * SSMW * SSMW * 2);
    w.SKb = (bf16_t*)take((size_t)NL * PH * 2 * PK * PHALF * 2);
    w.Ub = (bf16_t*)take((size_t)NL * PE * DM * 2);
    w.Vb = (bf16_t*)take((size_t)NL * PE * DM * 2);
    w.xres = (float*)take((size_t)T * DM * 4);
    w.xb = (bf16_t*)take((size_t)T * DM * 2);
    w.rs1 = (float*)take((size_t)T * 4);
    w.rs2 = (float*)take((size_t)T * 4);
    w.proj = (bf16_t*)take((size_t)T * INW * 2);
    w.yssm = (bf16_t*)take((size_t)T * SSMW * 2);
    w.ydil = (bf16_t*)take((size_t)T * DILW * 2);
    w.cat = (bf16_t*)take((size_t)T * DM * 2);
    w.q = (bf16_t*)take((size_t)T * 2048 * 2);
    w.pidx = (int*)take((size_t)T * 128 * 4);
    w.pgate = (float*)take((size_t)T * 128 * 4);
    return o;
}

__global__ void k_transpose_w(const float* __restrict__ in, const float* __restrict__ gain, bf16_t* __restrict__ out, int K, int N) {
    __shared__ float tile[32][33];
    const int l = blockIdx.z;
    in += (size_t)l * K * N; out += (size_t)l * K * N; if (gain) gain += (size_t)l * K;
    const int n0 = blockIdx.x * 32, k0 = blockIdx.y * 32, tx = threadIdx.x, ty = threadIdx.y;
#pragma unroll
    for (int i = 0; i < 4; ++i) { const int k = k0 + ty + 8 * i; tile[ty + 8 * i][tx] = in[(size_t)k * N + n0 + tx] * (gain ? gain[k] : 1.0f); }
    __syncthreads();
#pragma unroll
    for (int i = 0; i < 4; ++i) { const int n = n0 + ty + 8 * i; out[(size_t)n * K + k0 + tx] = f2bf(tile[tx][ty + 8 * i]); }
}
__global__ void k_convert(const float* __restrict__ in, const float* __restrict__ gain, bf16_t* __restrict__ out, size_t n8, int cols, size_t elems_per_layer) {
    size_t i = (size_t)blockIdx.x * blockDim.x + threadIdx.x;
    const size_t stride = (size_t)gridDim.x * blockDim.x;
    for (; i < n8; i += stride) {
        const size_t e = i * 8;
        const f32x4 a = *(const f32x4*)(in + e), b = *(const f32x4*)(in + e + 4);
        f32x4 ga = {1.f, 1.f, 1.f, 1.f}, gb = ga;
        if (gain) { const size_t l = e / elems_per_layer; const int c = (int)(e % (size_t)cols); ga = *(const f32x4*)(gain + l * cols + c); gb = *(const f32x4*)(gain + l * cols + c + 4); }
        u32x4 w; w.x = pk2(a[0] * ga[0], a[1] * ga[1]); w.y = pk2(a[2] * ga[2], a[3] * ga[3]); w.z = pk2(b[0] * gb[0], b[1] * gb[1]); w.w = pk2(b[2] * gb[2], b[3] * gb[3]);
        *(u32x4*)(out + e) = w;
    }
}
__global__ void k_rowstat(const float* __restrict__ x, float* __restrict__ xcopy, bf16_t* __restrict__ xb, float* __restrict__ rs) {
    const int row = blockIdx.x * 4 + (threadIdx.x >> 6), lane = threadIdx.x & 63;
    const float* xr = x + (size_t)row * DM;
    float ss = 0.f;
#pragma unroll
    for (int i = 0; i < 4; ++i) {
        const int c = (lane + 64 * i) * 4;
        const f32x4 v = *(const f32x4*)(xr + c);
        ss += v[0] * v[0] + v[1] * v[1] + v[2] * v[2] + v[3] * v[3];
        if (xcopy) *(f32x4*)(xcopy + (size_t)row * DM + c) = v;
        u32x2 w; w.x = pk2(v[0], v[1]); w.y = pk2(v[2], v[3]);
        *(u32x2*)(xb + (size_t)row * DM + c) = w;
    }
    ss = wave_sum(ss);
    if (lane == 0) rs[row] = rsqrtf(ss * (1.0f / DM) + EPS);
}

template <int EPI>
__global__ __launch_bounds__(256) void k_gemm_naive(const bf16_t* __restrict__ A, const bf16_t* __restrict__ Bt, int M, int N, int K,
                                                     const float* __restrict__ rs, bf16_t* __restrict__ outb, float* __restrict__ outf) {
    const int wave = threadIdx.x >> 6, lane = threadIdx.x & 63, fr = lane & 15, fq = lane >> 4;
    const int m0 = blockIdx.y * 128 + (wave >> 1) * 64, n0 = blockIdx.x * 128 + (wave & 1) * 64;
    f32x4 acc[4][4];
#pragma unroll
    for (int i = 0; i < 4; ++i)
#pragma unroll
        for (int j = 0; j < 4; ++j) acc[i][j] = (f32x4){0.f, 0.f, 0.f, 0.f};
    for (int k0 = 0; k0 < K; k0 += 32) {
        bf16x8 a[4], b[4];
#pragma unroll
        for (int i = 0; i < 4; ++i) a[i] = *(const bf16x8*)(A + (size_t)(m0 + 16 * i + fr) * K + k0 + 8 * fq);
#pragma unroll
        for (int j = 0; j < 4; ++j) b[j] = *(const bf16x8*)(Bt + (size_t)(n0 + 16 * j + fr) * K + k0 + 8 * fq);
#pragma unroll
        for (int i = 0; i < 4; ++i)
#pragma unroll
            for (int j = 0; j < 4; ++j) acc[i][j] = __builtin_amdgcn_mfma_f32_16x16x32_bf16(a[i], b[j], acc[i][j], 0, 0, 0);
    }
#pragma unroll
    for (int i = 0; i < 4; ++i)
#pragma unroll
        for (int r = 0; r < 4; ++r) {
            const int m = m0 + 16 * i + 4 * fq + r;
            const float sc = (EPI == 0) ? rs[m] : 1.0f;
#pragma unroll
            for (int j = 0; j < 4; ++j) {
                const int n = n0 + 16 * j + fr;
                if (EPI == 0) outb[(size_t)m * N + n] = f2bf(acc[i][j][r] * sc);
                else outf[(size_t)m * N + n] += acc[i][j][r];
            }
        }
}

__global__ __launch_bounds__(64) void k_ssm_naive(const bf16_t* __restrict__ proj, bf16_t* __restrict__ yssm,
                                                   const float* __restrict__ lam_re, const float* __restrict__ lam_im, const float* __restrict__ log_step,
                                                   const float* __restrict__ b_re, const float* __restrict__ b_im, const float* __restrict__ c_re, const float* __restrict__ c_im,
                                                   const float* __restrict__ dsk, int layer) {
    const int b = blockIdx.x / NG, g = blockIdx.x % NG, p = threadIdx.x;
    const size_t lg = (size_t)layer * NG + g;
    const float lr = lam_re[lg * NS + p], li = lam_im[lg * NS + p], dt = expf(log_step[lg]);
    const float mag = expf(lr * dt);
    const float sn = sinf(li * dt), cs = cosf(li * dt);
    const float lbr = mag * cs, lbi = mag * sn;
    const float nr = lbr - 1.0f, ni = lbi, den = lr * lr + li * li;
    const float kr = (nr * lr + ni * li) / den, ki = (ni * lr - nr * li) / den;
    float Br[GC], Bi[GC], Cr[GC], Ci[GC], Dk[GC];
#pragma unroll
    for (int c = 0; c < GC; ++c) {
        const float br = b_re[(lg * NS + p) * GC + c], bi = b_im[(lg * NS + p) * GC + c];
        Br[c] = kr * br - ki * bi; Bi[c] = kr * bi + ki * br;
        Cr[c] = c_re[(lg * GC + c) * NS + p]; Ci[c] = c_im[(lg * GC + c) * NS + p];
        Dk[c] = dsk[(size_t)layer * SSMW + g * GC + c];
    }
    float xr = 0.f, xi = 0.f;
    for (int t = 0; t < SEQ; ++t) {
        const size_t row = (size_t)b * SEQ + t;
        const u32x4 w0 = *(const u32x4*)(proj + row * INW + g * GC), w1 = *(const u32x4*)(proj + row * INW + g * GC + 8);
        float u[GC];
        u[0] = lo_bf(w0.x); u[1] = hi_bf(w0.x); u[2] = lo_bf(w0.y); u[3] = hi_bf(w0.y); u[4] = lo_bf(w0.z); u[5] = hi_bf(w0.z); u[6] = lo_bf(w0.w); u[7] = hi_bf(w0.w);
        u[8] = lo_bf(w1.x); u[9] = hi_bf(w1.x); u[10] = lo_bf(w1.y); u[11] = hi_bf(w1.y); u[12] = lo_bf(w1.z); u[13] = hi_bf(w1.z); u[14] = lo_bf(w1.w); u[15] = hi_bf(w1.w);
        float bur = 0.f, bui = 0.f;
#pragma unroll
        for (int c = 0; c < GC; ++c) { bur += Br[c] * u[c]; bui += Bi[c] * u[c]; }
        const float nxr = lbr * xr - lbi * xi + bur, nxi = lbr * xi + lbi * xr + bui;
        xr = nxr; xi = nxi;
        float y[GC];
#pragma unroll
        for (int c = 0; c < GC; ++c) y[c] = Cr[c] * xr - Ci[c] * xi;
        float y8[8], y4[4], y2[2], y1;
        { const bool hb = (p & 1) != 0;
#pragma unroll
          for (int i = 0; i < 8; ++i) { const float keep = hb ? y[2 * i + 1] : y[2 * i], send = hb ? y[2 * i] : y[2 * i + 1]; y8[i] = keep + __shfl_xor(send, 1); } }
        { const bool hb = (p & 2) != 0;
#pragma unroll
          for (int i = 0; i < 4; ++i) { const float keep = hb ? y8[2 * i + 1] : y8[2 * i], send = hb ? y8[2 * i] : y8[2 * i + 1]; y4[i] = keep + __shfl_xor(send, 2); } }
        { const bool hb = (p & 4) != 0;
#pragma unroll
          for (int i = 0; i < 2; ++i) { const float keep = hb ? y4[2 * i + 1] : y4[2 * i], send = hb ? y4[2 * i] : y4[2 * i + 1]; y2[i] = keep + __shfl_xor(send, 4); } }
        { const bool hb = (p & 8) != 0; const float keep = hb ? y2[1] : y2[0], send = hb ? y2[0] : y2[1]; y1 = keep + __shfl_xor(send, 8); }
        y1 += __shfl_xor(y1, 16); y1 += __shfl_xor(y1, 32);
        if (p < GC) {
            float uc = 0.f, dc = 0.f;
#pragma unroll
            for (int c = 0; c < GC; ++c) { uc = (c == p) ? u[c] : uc; dc = (c == p) ? Dk[c] : dc; }
            yssm[row * SSMW + g * GC + p] = f2bf(y1 + dc * uc);
        }
    }
}

__global__ __launch_bounds__(64) void k_dil_naive(const bf16_t* __restrict__ proj, bf16_t* __restrict__ ydil) {
    const int gid = blockIdx.x * 64 + threadIdx.x;
    const int t = gid % SEQ, hd = (gid / SEQ) % DILH, b = gid / (SEQ * DILH);
    const size_t row = (size_t)b * SEQ + t;
    unsigned qp[32];
#pragma unroll
    for (int i = 0; i < 8; ++i) { const u32x4 w = *(const u32x4*)(proj + row * INW + OFF_DQ + hd * 64 + 8 * i); qp[4 * i] = w.x; qp[4 * i + 1] = w.y; qp[4 * i + 2] = w.z; qp[4 * i + 3] = w.w; }
    float O[64]; float L = -INFINITY;
#pragma unroll
    for (int d = 0; d < 64; ++d) O[d] = 0.f;

    for (int pt = 0; pt < 3; ++pt) {
        const int dl = 1 << (2 * pt), win = (pt == 0) ? 128 : (pt == 1 ? 512 : 2048), nj = win / dl + 1;
        float m = -INFINITY, den = 0.f; float acc[64];
#pragma unroll
        for (int d = 0; d < 64; ++d) acc[d] = 0.f;
        for (int j = 0; j < nj; ++j) {
            const int idx = t - dl * j; if (idx < 0) break;
            const size_t kr = (size_t)b * SEQ + idx;
            float s = 0.f;
#pragma unroll
            for (int i = 0; i < 8; ++i) {
                const u32x4 w = *(const u32x4*)(proj + kr * INW + OFF_DK + hd * 64 + 8 * i);
                s += lo_bf(qp[4 * i]) * lo_bf(w.x) + hi_bf(qp[4 * i]) * hi_bf(w.x) + lo_bf(qp[4 * i + 1]) * lo_bf(w.y) + hi_bf(qp[4 * i + 1]) * hi_bf(w.y)
                   + lo_bf(qp[4 * i + 2]) * lo_bf(w.z) + hi_bf(qp[4 * i + 2]) * hi_bf(w.z) + lo_bf(qp[4 * i + 3]) * lo_bf(w.w) + hi_bf(qp[4 * i + 3]) * hi_bf(w.w);
            }
            s *= 0.125f;
            const float mn = fmaxf(m, s), al = expf(m - mn), pp = expf(s - mn);
            den = den * al + pp; m = mn;
#pragma unroll
            for (int i = 0; i < 8; ++i) {
                const u32x4 w = *(const u32x4*)(proj + kr * INW + OFF_DV + hd * 64 + 8 * i);
                acc[8 * i + 0] = acc[8 * i + 0] * al + pp * lo_bf(w.x); acc[8 * i + 1] = acc[8 * i + 1] * al + pp * hi_bf(w.x);
                acc[8 * i + 2] = acc[8 * i + 2] * al + pp * lo_bf(w.y); acc[8 * i + 3] = acc[8 * i + 3] * al + pp * hi_bf(w.y);
                acc[8 * i + 4] = acc[8 * i + 4] * al + pp * lo_bf(w.z); acc[8 * i + 5] = acc[8 * i + 5] * al + pp * hi_bf(w.z);
                acc[8 * i + 6] = acc[8 * i + 6] * al + pp * lo_bf(w.w); acc[8 * i + 7] = acc[8 * i + 7] * al + pp * hi_bf(w.w);
            }
        }
        const float lse = m + logf(den), inv = 1.0f / den;
        const float Ln = fmaxf(L, lse) + logf(expf(L - fmaxf(L, lse)) + expf(lse - fmaxf(L, lse)));
        const float wo = expf(L - Ln), wn = expf(lse - Ln) * inv;
#pragma unroll
        for (int d = 0; d < 64; ++d) O[d] = O[d] * wo + acc[d] * wn;
        L = Ln;
    }
#pragma unroll
    for (int i = 0; i < 8; ++i) {
        u32x4 w; w.x = pk2(O[8 * i], O[8 * i + 1]); w.y = pk2(O[8 * i + 2], O[8 * i + 3]); w.z = pk2(O[8 * i + 4], O[8 * i + 5]); w.w = pk2(O[8 * i + 6], O[8 * i + 7]);
        *(u32x4*)(ydil + row * DILW + hd * 64 + 8 * i) = w;
    }
}

__global__ __launch_bounds__(64) void k_diff_naive(const bf16_t* __restrict__ proj, bf16_t* __restrict__ cat,
                                                    const float* __restrict__ lq1, const float* __restrict__ lk1, const float* __restrict__ lq2, const float* __restrict__ lk2,
                                                    const float* __restrict__ subg, int layer) {
    const int gid = blockIdx.x * 64 + threadIdx.x;
    const int t = gid % SEQ, hd = (gid / SEQ) % DIFH, b = gid / (SEQ * DIFH);
    const size_t row = (size_t)b * SEQ + t;
    const float lam_init = 0.8f - 0.6f * expf(-0.3f * (float)layer);
    float s1 = 0.f, s2 = 0.f;
    for (int i = 0; i < 32; ++i) { s1 += lq1[layer * 32 + i] * lk1[layer * 32 + i]; s2 += lq2[layer * 32 + i] * lk2[layer * 32 + i]; }
    const float lam = expf(s1) - expf(s2) + lam_init;
    unsigned qp[32];
#pragma unroll
    for (int i = 0; i < 8; ++i) { const u32x4 w = *(const u32x4*)(proj + row * INW + OFF_FQ + hd * 64 + 8 * i); qp[4 * i] = w.x; qp[4 * i + 1] = w.y; qp[4 * i + 2] = w.z; qp[4 * i + 3] = w.w; }
    float O1[64], O2[64]; float m1 = -INFINITY, m2 = -INFINITY, d1 = 0.f, d2 = 0.f;
#pragma unroll
    for (int d = 0; d < 64; ++d) { O1[d] = 0.f; O2[d] = 0.f; }
    const float scale = 0.17677669529663687f;
    for (int j = 0; j <= t; ++j) {
        const size_t kr = (size_t)b * SEQ + j;
        float sa = 0.f, sb = 0.f;
#pragma unroll
        for (int i = 0; i < 4; ++i) {
            const u32x4 w = *(const u32x4*)(proj + kr * INW + OFF_FK + hd * 64 + 8 * i);
            sa += lo_bf(qp[4 * i]) * lo_bf(w.x) + hi_bf(qp[4 * i]) * hi_bf(w.x) + lo_bf(qp[4 * i + 1]) * lo_bf(w.y) + hi_bf(qp[4 * i + 1]) * hi_bf(w.y)
                + lo_bf(qp[4 * i + 2]) * lo_bf(w.z) + hi_bf(qp[4 * i + 2]) * hi_bf(w.z) + lo_bf(qp[4 * i + 3]) * lo_bf(w.w) + hi_bf(qp[4 * i + 3]) * hi_bf(w.w);
        }
#pragma unroll
        for (int i = 4; i < 8; ++i) {
            const u32x4 w = *(const u32x4*)(proj + kr * INW + OFF_FK + hd * 64 + 8 * i);
            sb += lo_bf(qp[4 * i]) * lo_bf(w.x) + hi_bf(qp[4 * i]) * hi_bf(w.x) + lo_bf(qp[4 * i + 1]) * lo_bf(w.y) + hi_bf(qp[4 * i + 1]) * hi_bf(w.y)
                + lo_bf(qp[4 * i + 2]) * lo_bf(w.z) + hi_bf(qp[4 * i + 2]) * hi_bf(w.z) + lo_bf(qp[4 * i + 3]) * lo_bf(w.w) + hi_bf(qp[4 * i + 3]) * hi_bf(w.w);
        }
        sa *= scale; sb *= scale;
        const float mn1 = fmaxf(m1, sa), a1 = expf(m1 - mn1), p1 = expf(sa - mn1); d1 = d1 * a1 + p1; m1 = mn1;
        const float mn2 = fmaxf(m2, sb), a2 = expf(m2 - mn2), p2 = expf(sb - mn2); d2 = d2 * a2 + p2; m2 = mn2;
#pragma unroll
        for (int i = 0; i < 8; ++i) {
            const u32x4 w = *(const u32x4*)(proj + kr * INW + OFF_FV + hd * 64 + 8 * i);
            const float v0 = lo_bf(w.x), v1 = hi_bf(w.x), v2 = lo_bf(w.y), v3 = hi_bf(w.y), v4 = lo_bf(w.z), v5 = hi_bf(w.z), v6 = lo_bf(w.w), v7 = hi_bf(w.w);
            O1[8 * i + 0] = O1[8 * i + 0] * a1 + p1 * v0; O1[8 * i + 1] = O1[8 * i + 1] * a1 + p1 * v1; O1[8 * i + 2] = O1[8 * i + 2] * a1 + p1 * v2; O1[8 * i + 3] = O1[8 * i + 3] * a1 + p1 * v3;
            O1[8 * i + 4] = O1[8 * i + 4] * a1 + p1 * v4; O1[8 * i + 5] = O1[8 * i + 5] * a1 + p1 * v5; O1[8 * i + 6] = O1[8 * i + 6] * a1 + p1 * v6; O1[8 * i + 7] = O1[8 * i + 7] * a1 + p1 * v7;
            O2[8 * i + 0] = O2[8 * i + 0] * a2 + p2 * v0; O2[8 * i + 1] = O2[8 * i + 1] * a2 + p2 * v1; O2[8 * i + 2] = O2[8 * i + 2] * a2 + p2 * v2; O2[8 * i + 3] = O2[8 * i + 3] * a2 + p2 * v3;
            O2[8 * i + 4] = O2[8 * i + 4] * a2 + p2 * v4; O2[8 * i + 5] = O2[8 * i + 5] * a2 + p2 * v5; O2[8 * i + 6] = O2[8 * i + 6] * a2 + p2 * v6; O2[8 * i + 7] = O2[8 * i + 7] * a2 + p2 * v7;
        }
    }
    const float i1 = 1.0f / d1, i2 = lam / d2;
    float ss = 0.f;
#pragma unroll
    for (int d = 0; d < 64; ++d) { O1[d] = O1[d] * i1 - O2[d] * i2; ss += O1[d] * O1[d]; }
    const float rn = rsqrtf(ss * (1.0f / 64.0f) + EPS) * (1.0f - lam_init);
#pragma unroll
    for (int i = 0; i < 8; ++i) {
        float o[8];
#pragma unroll
        for (int e = 0; e < 8; ++e) o[e] = O1[8 * i + e] * rn * subg[layer * 64 + 8 * i + e];
        u32x4 w; w.x = pk2(o[0], o[1]); w.y = pk2(o[2], o[3]); w.z = pk2(o[4], o[5]); w.w = pk2(o[6], o[7]);
        *(u32x4*)(cat + row * DM + 768 + hd * 64 + 8 * i) = w;
    }
}

__global__ __launch_bounds__(384) void k_b2_naive(const bf16_t* __restrict__ yssm, const bf16_t* __restrict__ ydil, bf16_t* __restrict__ cat,
                                                   const bf16_t* __restrict__ WgluT, const float* __restrict__ ssm_g, const float* __restrict__ dil_g, int layer) {
    __shared__ float gs[SSMW]; __shared__ float red[16];
    const int t = blockIdx.x, n = threadIdx.x, lane = n & 63, wv = n >> 6;
    const float gy = gelu_tanh(bf2f(yssm[(size_t)t * SSMW + n]));
    gs[n] = gy;
    __syncthreads();
    const bf16_t* wr = WgluT + ((size_t)layer * SSMW + n) * SSMW;
    float z = 0.f;
    for (int k = 0; k < SSMW; k += 8) {
        const u32x4 w = *(const u32x4*)(wr + k);
        z += gs[k] * lo_bf(w.x) + gs[k + 1] * hi_bf(w.x) + gs[k + 2] * lo_bf(w.y) + gs[k + 3] * hi_bf(w.y) + gs[k + 4] * lo_bf(w.z) + gs[k + 5] * hi_bf(w.z) + gs[k + 6] * lo_bf(w.w) + gs[k + 7] * hi_bf(w.w);
    }
    const float y2 = gy * (1.0f / (1.0f + expf(-z)));
    const float yd = bf2f(ydil[(size_t)t * DILW + n]);
    float s1 = wave_sum(y2 * y2), s2 = wave_sum(yd * yd);
    if (lane == 0) { red[wv] = s1; red[8 + wv] = s2; }
    __syncthreads();
    float t1 = 0.f, t2 = 0.f;
#pragma unroll
    for (int i = 0; i < 6; ++i) { t1 += red[i]; t2 += red[8 + i]; }
    const float r1 = rsqrtf(t1 * (1.0f / SSMW) + EPS), r2 = rsqrtf(t2 * (1.0f / DILW) + EPS);
    cat[(size_t)t * DM + n] = f2bf(y2 * r1 * ssm_g[layer * SSMW + n]);
    cat[(size_t)t * DM + SSMW + n] = f2bf(yd * r2 * dil_g[layer * DILW + n]);
}

__device__ __forceinline__ void wave_argmax(float& bv, int& bi) {
#pragma unroll
    for (int o = 32; o >= 1; o >>= 1) {
        const float ov = __shfl_xor(bv, o); const int oi = __shfl_xor(bi, o);
        if (ov > bv || (ov == bv && oi < bi)) { bv = ov; bi = oi; }
    }
}
__global__ __launch_bounds__(256) void k_route_naive(const bf16_t* __restrict__ q, const bf16_t* __restrict__ SKb, int* __restrict__ pidx, float* __restrict__ pgate, int layer) {
    __shared__ float qs[4][PQD];
    const int wv = threadIdx.x >> 6, lane = threadIdx.x & 63;
    const int th = blockIdx.x * 4 + wv, t = th >> 3, h = th & 7;
    { const u32x2 w = *(const u32x2*)(q + (size_t)t * 2048 + h * PQD + 4 * lane);
      qs[wv][4 * lane] = lo_bf(w.x); qs[wv][4 * lane + 1] = hi_bf(w.x); qs[wv][4 * lane + 2] = lo_bf(w.y); qs[wv][4 * lane + 3] = hi_bf(w.y); }
    __syncthreads();
    float sc[2][2];
#pragma unroll
    for (int c = 0; c < 2; ++c)
#pragma unroll
        for (int i = 0; i < 2; ++i) {
            const bf16_t* kr = SKb + ((((size_t)layer * PH + h) * 2 + c) * PK + lane + 64 * i) * PHALF;
            float s = 0.f;
            for (int d = 0; d < PHALF; d += 8) {
                const u32x4 w = *(const u32x4*)(kr + d);
                const float* qq = &qs[wv][c * PHALF + d];
                s += qq[0] * lo_bf(w.x) + qq[1] * hi_bf(w.x) + qq[2] * lo_bf(w.y) + qq[3] * hi_bf(w.y) + qq[4] * lo_bf(w.z) + qq[5] * hi_bf(w.z) + qq[6] * lo_bf(w.w) + qq[7] * hi_bf(w.w);
            }
            sc[c][i] = s;
        }
    float ts[2]; int ti[2];
    ts[0] = ts[1] = 0.f; ti[0] = ti[1] = 0;
#pragma unroll
    for (int c = 0; c < 2; ++c) {
        float v0 = sc[c][0], v1 = sc[c][1];
        for (int r = 0; r < PTOP; ++r) {
            float bv; int bi;
            if (v0 >= v1) { bv = v0; bi = lane; } else { bv = v1; bi = lane + 64; }
            wave_argmax(bv, bi);
            if (lane == r) { ts[c] = bv; ti[c] = bi; }
            if (bi == lane) v0 = -INFINITY;
            if (bi == lane + 64) v1 = -INFINITY;
        }
    }
    float cv[4];
#pragma unroll
    for (int m = 0; m < 4; ++m) { const int f = lane + 64 * m; cv[m] = __shfl(ts[0], f >> 4) + __shfl(ts[1], f & 15); }
    float bs = 0.f; int bj = 0;
    for (int r = 0; r < PTOP; ++r) {
        float bv = cv[0]; int bi = lane;
#pragma unroll
        for (int m = 1; m < 4; ++m) if (cv[m] > bv) { bv = cv[m]; bi = lane + 64 * m; }
        wave_argmax(bv, bi);
        if (lane == r) { bs = bv; bj = bi; }
#pragma unroll
        for (int m = 0; m < 4; ++m) if (bi == lane + 64 * m) cv[m] = -INFINITY;
    }
    const int ia = __shfl(ti[0], bj >> 4), ib = __shfl(ti[1], bj & 15);
    const float mx = __shfl(bs, 0);
    float e = (lane < PTOP) ? expf(bs - mx) : 0.f;
    const float sum = wave_sum(e);
    if (lane < PTOP) { pidx[(size_t)t * 128 + h * PTOP + lane] = ia * PK + ib; pgate[(size_t)t * 128 + h * PTOP + lane] = e / sum; }
}

__global__ __launch_bounds__(256) void k_peer_naive(float* __restrict__ xres, const float* __restrict__ rs2, const int* __restrict__ pidx, const float* __restrict__ pgate,
                                                     const bf16_t* __restrict__ Ub, const bf16_t* __restrict__ Vb, int layer, const float* __restrict__ fin_g, float* __restrict__ out) {
    const int t = blockIdx.x * 4 + (threadIdx.x >> 6), lane = threadIdx.x & 63;
    float x[16], acc[16];
    float* xr = xres + (size_t)t * DM;
#pragma unroll
    for (int i = 0; i < 2; ++i) { const f32x4 a = *(const f32x4*)(xr + 512 * i + 8 * lane), b = *(const f32x4*)(xr + 512 * i + 8 * lane + 4);
        x[8 * i] = a[0]; x[8 * i + 1] = a[1]; x[8 * i + 2] = a[2]; x[8 * i + 3] = a[3]; x[8 * i + 4] = b[0]; x[8 * i + 5] = b[1]; x[8 * i + 6] = b[2]; x[8 * i + 7] = b[3]; }
#pragma unroll
    for (int i = 0; i < 16; ++i) acc[i] = 0.f;
    const float rs = rs2[t];
    const bf16_t* U = Ub + (size_t)layer * PE * DM; const bf16_t* V = Vb + (size_t)layer * PE * DM;
    for (int p = 0; p < 128; ++p) {
        const int e = pidx[(size_t)t * 128 + p]; const float g = pgate[(size_t)t * 128 + p];
        const u32x4 u0 = *(const u32x4*)(U + (size_t)e * DM + 8 * lane), u1 = *(const u32x4*)(U + (size_t)e * DM + 512 + 8 * lane);
        float dot = x[0] * lo_bf(u0.x) + x[1] * hi_bf(u0.x) + x[2] * lo_bf(u0.y) + x[3] * hi_bf(u0.y) + x[4] * lo_bf(u0.z) + x[5] * hi_bf(u0.z) + x[6] * lo_bf(u0.w) + x[7] * hi_bf(u0.w)
                  + x[8] * lo_bf(u1.x) + x[9] * hi_bf(u1.x) + x[10] * lo_bf(u1.y) + x[11] * hi_bf(u1.y) + x[12] * lo_bf(u1.z) + x[13] * hi_bf(u1.z) + x[14] * lo_bf(u1.w) + x[15] * hi_bf(u1.w);
        dot = wave_sum(dot);
        const float cf = g * gelu_tanh(dot * rs);
        const u32x4 v0 = *(const u32x4*)(V + (size_t)e * DM + 8 * lane), v1 = *(const u32x4*)(V + (size_t)e * DM + 512 + 8 * lane);
        acc[0] += cf * lo_bf(v0.x); acc[1] += cf * hi_bf(v0.x); acc[2] += cf * lo_bf(v0.y); acc[3] += cf * hi_bf(v0.y); acc[4] += cf * lo_bf(v0.z); acc[5] += cf * hi_bf(v0.z); acc[6] += cf * lo_bf(v0.w); acc[7] += cf * hi_bf(v0.w);
        acc[8] += cf * lo_bf(v1.x); acc[9] += cf * hi_bf(v1.x); acc[10] += cf * lo_bf(v1.y); acc[11] += cf * hi_bf(v1.y); acc[12] += cf * lo_bf(v1.z); acc[13] += cf * hi_bf(v1.z); acc[14] += cf * lo_bf(v1.w); acc[15] += cf * hi_bf(v1.w);
    }
    float ss = 0.f;
#pragma unroll
    for (int i = 0; i < 16; ++i) { x[i] += acc[i]; ss += x[i] * x[i]; }
    if (out) {
        ss = wave_sum(ss);
        const float rn = rsqrtf(ss * (1.0f / DM) + EPS);
#pragma unroll
        for (int i = 0; i < 2; ++i) {
            const f32x4 ga = *(const f32x4*)(fin_g + 512 * i + 8 * lane), gb = *(const f32x4*)(fin_g + 512 * i + 8 * lane + 4);
            f32x4 a = {x[8 * i] * rn * ga[0], x[8 * i + 1] * rn * ga[1], x[8 * i + 2] * rn * ga[2], x[8 * i + 3] * rn * ga[3]};
            f32x4 b = {x[8 * i + 4] * rn * gb[0], x[8 * i + 5] * rn * gb[1], x[8 * i + 6] * rn * gb[2], x[8 * i + 7] * rn * gb[3]};
            *(f32x4*)(out + (size_t)t * DM + 512 * i + 8 * lane) = a; *(f32x4*)(out + (size_t)t * DM + 512 * i + 8 * lane + 4) = b;
        }
    } else {
#pragma unroll
        for (int i = 0; i < 2; ++i) {
            f32x4 a = {x[8 * i], x[8 * i + 1], x[8 * i + 2], x[8 * i + 3]}, b = {x[8 * i + 4], x[8 * i + 5], x[8 * i + 6], x[8 * i + 7]};
            *(f32x4*)(xr + 512 * i + 8 * lane) = a; *(f32x4*)(xr + 512 * i + 8 * lane + 4) = b;
        }
    }
}

extern "C" void kernel_launch(void* const* d_in, const int* in_sizes, int n_in, void* d_out, int out_size, void* d_ws, size_t ws_size, hipStream_t stream) {
    WS w; const size_t need = ws_carve((unsigned char*)d_ws, w);
    if (n_in != 26 || out_size != T * DM || ws_size < need) { fprintf(stderr, "kernel_launch: unexpected shapes (n_in %d out %d ws %zu need %zu)\n", n_in, out_size, ws_size, need); return; }
    const float* x = (const float*)d_in[0]; const float* norm1_g = (const float*)d_in[1]; const float* w_in = (const float*)d_in[2];
    const float* lam_re = (const float*)d_in[3]; const float* lam_im = (const float*)d_in[4]; const float* log_step = (const float*)d_in[5];
    const float* b_re = (const float*)d_in[6]; const float* b_im = (const float*)d_in[7]; const float* c_re = (const float*)d_in[8]; const float* c_im = (const float*)d_in[9];
    const float* ssm_d = (const float*)d_in[10]; const float* w_glu = (const float*)d_in[11]; const float* ssm_g = (const float*)d_in[12]; const float* dil_g = (const float*)d_in[13];
    const float* lq1 = (const float*)d_in[14]; const float* lk1 = (const float*)d_in[15]; const float* lq2 = (const float*)d_in[16]; const float* lk2 = (const float*)d_in[17];
    const float* subg = (const float*)d_in[18]; const float* w_out = (const float*)d_in[19]; const float* norm2_g = (const float*)d_in[20];
    const float* w_query = (const float*)d_in[21]; const float* sub_keys = (const float*)d_in[22]; const float* peer_u = (const float*)d_in[23]; const float* peer_v = (const float*)d_in[24];
    const float* fin_g = (const float*)d_in[25];
    float* out = (float*)d_out;

    k_transpose_w<<<dim3(INW / 32, DM / 32, NL), dim3(32, 8), 0, stream>>>(w_in, norm1_g, w.WinT, DM, INW);
    k_transpose_w<<<dim3(DM / 32, DM / 32, NL), dim3(32, 8), 0, stream>>>(w_out, nullptr, w.WoutT, DM, DM);
    k_transpose_w<<<dim3(2048 / 32, DM / 32, NL), dim3(32, 8), 0, stream>>>(w_query, norm2_g, w.WqT, DM, 2048);
    k_transpose_w<<<dim3(SSMW / 32, SSMW / 32, NL), dim3(32, 8), 0, stream>>>(w_glu, nullptr, w.WgluT, SSMW, SSMW);
    k_convert<<<512, 256, 0, stream>>>(sub_keys, nullptr, w.SKb, (size_t)NL * PH * 2 * PK * PHALF / 8, PHALF, 1);
    k_convert<<<2048, 256, 0, stream>>>(peer_u, norm2_g, w.Ub, (size_t)NL * PE * DM / 8, DM, (size_t)PE * DM);
    k_convert<<<2048, 256, 0, stream>>>(peer_v, nullptr, w.Vb, (size_t)NL * PE * DM / 8, DM, (size_t)PE * DM);
    k_rowstat<<<T / 4, 256, 0, stream>>>(x, w.xres, w.xb, w.rs1);

    for (int l = 0; l < NL; ++l) {
        k_gemm_naive<0><<<dim3(INW / 128, T / 128), 256, 0, stream>>>(w.xb, w.WinT + (size_t)l * INW * DM, T, INW, DM, w.rs1, w.proj, nullptr);
        k_ssm_naive<<<NB * NG, 64, 0, stream>>>(w.proj, w.yssm, lam_re, lam_im, log_step, b_re, b_im, c_re, c_im, ssm_d, l);
        k_dil_naive<<<NB * DILH * SEQ / 64, 64, 0, stream>>>(w.proj, w.ydil);
        k_diff_naive<<<NB * DIFH * SEQ / 64, 64, 0, stream>>>(w.proj, w.cat, lq1, lk1, lq2, lk2, subg, l);
        k_b2_naive<<<T, 384, 0, stream>>>(w.yssm, w.ydil, w.cat, w.WgluT, ssm_g, dil_g, l);
        k_gemm_naive<1><<<dim3(DM / 128, T / 128), 256, 0, stream>>>(w.cat, w.WoutT + (size_t)l * DM * DM, T, DM, DM, nullptr, nullptr, w.xres);
        k_rowstat<<<T / 4, 256, 0, stream>>>(w.xres, nullptr, w.xb, w.rs2);
        k_gemm_naive<0><<<dim3(2048 / 128, T / 128), 256, 0, stream>>>(w.xb, w.WqT + (size_t)l * 2048 * DM, T, 2048, DM, w.rs2, w.q, nullptr);
        k_route_naive<<<T * PH / 4, 256, 0, stream>>>(w.q, w.SKb, w.pidx, w.pgate, l);
        k_peer_naive<<<T / 4, 256, 0, stream>>>(w.xres, w.rs2, w.pidx, w.pgate, w.Ub, w.Vb, l, fin_g, (l == NL - 1) ? out : nullptr);
        if (l != NL - 1) k_rowstat<<<T / 4, 256, 0, stream>>>(w.xres, nullptr, w.xb, w.rs1);
    }
}
```

```cpp
#include <hip/hip_runtime.h>
#include <hip/hip_cooperative_groups.h>
#include <cstdint>
#include <cstdio>
#include <cmath>

typedef unsigned short bf16_t;
typedef short bf16x8 __attribute__((ext_vector_type(8)));
typedef float f32x4 __attribute__((ext_vector_type(4)));
typedef unsigned u32x4 __attribute__((ext_vector_type(4)));
typedef unsigned u32x2 __attribute__((ext_vector_type(2)));
typedef float f32x2 __attribute__((ext_vector_type(2)));
#define LAS __attribute__((address_space(3)))

constexpr int T = 16384, DM = 1024, NL = 4, SEQ = 2048, NB = 8;
constexpr int INW = 2304;
constexpr int SSMW = 384, DILW = 384, DIFW = 256;
constexpr int NG = 24, GC = 16, NS = 64;
constexpr int DILH = 6, DIFH = 4;
constexpr int PH = 8, PK = 128, PE = 16384, PTOP = 16, PQD = 256, PHALF = 128;
constexpr int OFF_DQ = 384, OFF_DK = 768, OFF_DV = 1152, OFF_FQ = 1536, OFF_FK = 1792, OFF_FV = 2048;
constexpr float EPS = 1e-6f;
constexpr float PEER_USCALE = 64.0f, PEER_VSCALE = 4.0f;
constexpr int XCD_BAR_WORDS_C = 3456;

__device__ __forceinline__ float bf2f(bf16_t h) { return __uint_as_float(((unsigned)h) << 16); }
__device__ __forceinline__ unsigned pk2(float a, float b) {
    typedef __bf16 bf2 __attribute__((ext_vector_type(2)));
    typedef float f2 __attribute__((ext_vector_type(2)));
    f2 v = {a, b};
    bf2 r = __builtin_convertvector(v, bf2);
    return __builtin_bit_cast(unsigned, r);
}
__device__ __forceinline__ bf16_t f2bf(float a) { return (bf16_t)(pk2(a, 0.f) & 0xffffu); }
__device__ __forceinline__ float lo_bf(unsigned w) { return __uint_as_float(w << 16); }
__device__ __forceinline__ float hi_bf(unsigned w) { return __uint_as_float(w & 0xffff0000u); }
template <int CTRL> __device__ __forceinline__ float dppmov(float v) { return __uint_as_float(__builtin_amdgcn_update_dpp(0u, __float_as_uint(v), CTRL, 0xf, 0xf, true)); }
constexpr int DPP_XOR1 = 0xB1, DPP_XOR2 = 0x4E, DPP_ROR4 = 0x124, DPP_ROR8 = 0x128;
__device__ __forceinline__ float swap16sum(float v) { const auto r = __builtin_amdgcn_permlane16_swap(__float_as_uint(v), __float_as_uint(v), false, false); return __uint_as_float(r[0]) + __uint_as_float(r[1]); }
__device__ __forceinline__ float swap32sum(float v) { const auto r = __builtin_amdgcn_permlane32_swap(__float_as_uint(v), __float_as_uint(v), false, false); return __uint_as_float(r[0]) + __uint_as_float(r[1]); }
__device__ __forceinline__ float wave_sum(float v) {
    v += dppmov<DPP_XOR1>(v); v += dppmov<DPP_XOR2>(v); v += dppmov<DPP_ROR4>(v); v += dppmov<DPP_ROR8>(v);
    return swap32sum(swap16sum(v));
}

struct WS {
    bf16_t *WinT, *WoutT, *WqT, *WgluT, *SKb; unsigned char *U8, *V8;
    bf16_t *xb, *xb1; float *rs1, *rs2, *ssqp;
    bf16_t *proj, *yssm, *ydil, *cat, *q, *dilO; float* dilL; unsigned* ctr;
    bf16_t *s5k, *s5we, *s5wo; unsigned* bar;
    int* pidx; float* pgate;
};
__host__ __device__ inline size_t ws_carve(unsigned char* base, WS& w) {
    size_t o = 0;
#define TAKE(ptr, type, bytes) do { ptr = (type)(base + o); o += (((size_t)(bytes)) + 255) & ~(size_t)255; } while (0)
    TAKE(w.WinT, bf16_t*, (size_t)NL * INW * DM * 2);
    TAKE(w.WoutT, bf16_t*, (size_t)NL * DM * DM * 2);
    TAKE(w.WqT, bf16_t*, (size_t)NL * 2048 * DM * 2);
    TAKE(w.WgluT, bf16_t*, (size_t)NL * SSMW * SSMW * 2);
    TAKE(w.SKb, bf16_t*, (size_t)NL * PH * 2 * PK * PHALF * 2);
    TAKE(w.U8, unsigned char*, (size_t)NL * PE * 768);
    TAKE(w.V8, unsigned char*, (size_t)NL * PE * 768);
    TAKE(w.xb, bf16_t*, (size_t)T * DM * 2);
    TAKE(w.xb1, bf16_t*, (size_t)T * DM * 2);
    TAKE(w.rs1, float*, (size_t)T * 4);
    TAKE(w.rs2, float*, (size_t)T * 4);
    TAKE(w.ssqp, float*, (size_t)T * 16 * 4);
    TAKE(w.proj, bf16_t*, (size_t)T * INW * 2);
    TAKE(w.yssm, bf16_t*, (size_t)T * SSMW * 2);
    TAKE(w.ydil, bf16_t*, (size_t)T * DILW * 2);
    TAKE(w.dilO, bf16_t*, (size_t)3 * T * DILW * 2);
    TAKE(w.dilL, float*, (size_t)3 * T * DILH * 4);
    TAKE(w.ctr, unsigned*, 4096);
    TAKE(w.bar, unsigned*, XCD_BAR_WORDS_C * 4);
    TAKE(w.s5k, bf16_t*, (size_t)NL * NG * 64 * 256 * 2);
    TAKE(w.s5we, bf16_t*, (size_t)NL * NG * 64 * 128 * 16 * 2);
    TAKE(w.s5wo, bf16_t*, (size_t)NL * NG * 64 * 128 * 16 * 2);
    TAKE(w.cat, bf16_t*, (size_t)T * DM * 2);
    TAKE(w.q, bf16_t*, (size_t)T * 2048 * 2);
    TAKE(w.pidx, int*, (size_t)T * 128 * 4);
    TAKE(w.pgate, float*, (size_t)T * 128 * 4);
#undef TAKE
    return o;
}

__device__ __forceinline__ void transpose_tile(float* tile, const float* __restrict__ in, const float* __restrict__ gain, bf16_t* __restrict__ out, int K, int N, int n0, int k0, int tid) {
#pragma unroll
    for (int i = 0; i < 2; ++i) {
        const int q = tid + 512 * i, kk = q >> 4, n4 = (q & 15) * 4;
        f32x4 v = *(const f32x4*)(in + (size_t)(k0 + kk) * N + n0 + n4);
        if (gain) v = v * gain[k0 + kk];
        tile[kk * 65 + n4] = v[0]; tile[kk * 65 + n4 + 1] = v[1]; tile[kk * 65 + n4 + 2] = v[2]; tile[kk * 65 + n4 + 3] = v[3];
    }
    __syncthreads();
    { const int n = tid >> 3, k8 = (tid & 7) * 8;
      u32x4 w; w.x = pk2(tile[(k8 + 0) * 65 + n], tile[(k8 + 1) * 65 + n]); w.y = pk2(tile[(k8 + 2) * 65 + n], tile[(k8 + 3) * 65 + n]);
      w.z = pk2(tile[(k8 + 4) * 65 + n], tile[(k8 + 5) * 65 + n]); w.w = pk2(tile[(k8 + 6) * 65 + n], tile[(k8 + 7) * 65 + n]);
      *(u32x4*)(out + (size_t)(n0 + n) * K + k0 + k8) = w; }
    __syncthreads();
}
__device__ __forceinline__ void convert_body(const float* __restrict__ in, const float* __restrict__ gain, bf16_t* __restrict__ out, size_t n8, int cols, size_t elems_per_layer, size_t gtid, size_t gstride) {
    size_t i = gtid;
    const size_t stride = gstride;
    for (; i < n8; i += stride) {
        const size_t e = i * 8;
        const f32x4 a = *(const f32x4*)(in + e), b = *(const f32x4*)(in + e + 4);
        f32x4 ga = {1.f, 1.f, 1.f, 1.f}, gb = ga;
        if (gain) { const size_t l = e / elems_per_layer; const int c = (int)(e % (size_t)cols); ga = *(const f32x4*)(gain + l * cols + c); gb = *(const f32x4*)(gain + l * cols + c + 4); }
        u32x4 w; w.x = pk2(a[0] * ga[0], a[1] * ga[1]); w.y = pk2(a[2] * ga[2], a[3] * ga[3]); w.z = pk2(b[0] * gb[0], b[1] * gb[1]); w.w = pk2(b[2] * gb[2], b[3] * gb[3]);
        *(u32x4*)(out + e) = w;
    }
}

typedef float f32x16v __attribute__((ext_vector_type(16)));
typedef unsigned u32x6 __attribute__((ext_vector_type(6)));
typedef unsigned u32x3 __attribute__((ext_vector_type(3)));
typedef float f32x32 __attribute__((ext_vector_type(32)));
__device__ __forceinline__ void convert_fp6_body(const float* __restrict__ in, const float* __restrict__ gain, unsigned char* __restrict__ data, int npairs, float scale, int gw, int nw, int lane) {
    if (gw >= npairs) return;
    f32x4 buf[3][8];
#define CF_LOAD(slot, pidx_) { const float* src_ = in + (size_t)(pidx_) * 2048 + 4 * lane; _Pragma("unroll") for (int k = 0; k < 8; ++k) buf[slot][k] = *(const f32x4*)(src_ + 256 * k); }
#define CF_PACK(slot, pidx_) { f32x16v ev, od; _Pragma("unroll") for (int k = 0; k < 8; ++k) { f32x4 v = buf[slot][k] * scale; \
            if (gain) { const int l_ = (pidx_) / (PE / 2); v = v * *(const f32x4*)(gain + l_ * DM + 256 * (k & 3) + 4 * lane); } \
            ev[2 * k] = v[0]; od[2 * k] = v[1]; ev[2 * k + 1] = v[2]; od[2 * k + 1] = v[3]; } \
        const u32x6 p = __builtin_amdgcn_cvt_scalef32_2xpk16_fp6_f32(ev, od, 1.0f); const u32x3 r0 = {p[0], p[1], p[2]}, r1 = {p[3], p[4], p[5]}; \
        *(u32x3*)(data + (size_t)(pidx_) * 1536 + 12 * lane) = r0; *(u32x3*)(data + (size_t)(pidx_) * 1536 + 768 + 12 * lane) = r1; }
    CF_LOAD(0, gw)
    if (gw + nw < npairs) CF_LOAD(1, gw + nw)
    for (int pr = gw; pr < npairs; pr += 3 * nw) {
        if (pr + 2 * nw < npairs) CF_LOAD(2, pr + 2 * nw)
        CF_PACK(0, pr)
        if (pr + nw >= npairs) break;
        if (pr + 3 * nw < npairs) CF_LOAD(0, pr + 3 * nw)
        CF_PACK(1, pr + nw)
        if (pr + 2 * nw >= npairs) break;
        if (pr + 4 * nw < npairs) CF_LOAD(1, pr + 4 * nw)
        CF_PACK(2, pr + 2 * nw)
    }
#undef CF_LOAD
#undef CF_PACK
}
__device__ __forceinline__ void rowstat_body(const float* __restrict__ x, float* __restrict__ xcopy, bf16_t* __restrict__ xb, float* __restrict__ rs, int row, int lane) {
    const float* xr = x + (size_t)row * DM;
    float ss = 0.f;
#pragma unroll
    for (int i = 0; i < 4; ++i) {
        const int c = (lane + 64 * i) * 4;
        const f32x4 v = *(const f32x4*)(xr + c);
        ss += v[0] * v[0] + v[1] * v[1] + v[2] * v[2] + v[3] * v[3];
        if (xcopy) *(f32x4*)(xcopy + (size_t)row * DM + c) = v;
        u32x2 w; w.x = pk2(v[0], v[1]); w.y = pk2(v[2], v[3]);
        *(u32x2*)(xb + (size_t)row * DM + c) = w;
    }
    ss = wave_sum(ss);
    if (lane == 0) rs[row] = rsqrtf(ss * (1.0f / DM) + EPS);
}

typedef __bf16 bf2_t __attribute__((ext_vector_type(2)));
__device__ __forceinline__ float gelu_fast(float x) {
    const float u = x + 0.044715f * x * x * x;
    return x * __builtin_amdgcn_rcpf(1.0f + __builtin_amdgcn_exp2f(-2.3022082f * u));
}
struct Rows4 { u32x3 u[4], v[4]; };
__device__ __forceinline__ void peer_load4(Rows4& R, const unsigned char* __restrict__ U, const unsigned char* __restrict__ V, int epk, int g, int lane) {
    unsigned lo = 12u * (unsigned)lane; asm volatile("" : "+v"(lo));
#pragma unroll
    for (int j = 0; j < 4; ++j) {
        const int p = g * 4 + j;
        const unsigned e = ((unsigned)__builtin_amdgcn_readlane(epk, p & 63) >> ((p >> 6) << 4)) & 0xffffu;
        const unsigned off = e * 768u + lo;
        R.u[j] = *(const u32x3*)(U + off);
        R.v[j] = *(const u32x3*)(V + off);
    }
}
__device__ __forceinline__ f32x32 fp6x32(const u32x3 a, const u32x3 b) { const u32x6 w = {a.x, a.y, a.z, b.x, b.y, b.z}; return __builtin_amdgcn_cvt_scalef32_pk32_f32_fp6(w, 1.0f); }
__device__ __forceinline__ void peer_compute4(const Rows4& R, float* acc, const float* x, float rs, unsigned gpk, int g, int lane) {
    float d[4];
#pragma unroll
    for (int q = 0; q < 2; ++q) {
        const f32x32 uf = fp6x32(R.u[2 * q], R.u[2 * q + 1]);
        f32x2 s0 = {0.f, 0.f}, s1 = {0.f, 0.f};
#pragma unroll
        for (int i = 0; i < 16; i += 2) { const f32x2 xv = {x[i], x[i + 1]}; s0 = __builtin_elementwise_fma((f32x2){uf[i], uf[i + 1]}, xv, s0); s1 = __builtin_elementwise_fma((f32x2){uf[16 + i], uf[17 + i]}, xv, s1); }
        d[2 * q] = s0.x + s0.y; d[2 * q + 1] = s1.x + s1.y;
    }
    const bool b0 = (lane & 1) != 0, b1 = (lane & 2) != 0;
    const float k0 = b0 ? d[1] : d[0], s0 = b0 ? d[0] : d[1], k1 = b0 ? d[3] : d[2], s1 = b0 ? d[2] : d[3];
    const float e0 = k0 + dppmov<DPP_XOR1>(s0), e1 = k1 + dppmov<DPP_XOR1>(s1);
    const float kk = b1 ? e1 : e0, ss = b1 ? e0 : e1;
    float dj = kk + dppmov<DPP_XOR2>(ss);
    dj += dppmov<DPP_ROR4>(dj); dj += dppmov<DPP_ROR8>(dj); dj = swap32sum(swap16sum(dj));
    const int p = g * 4 + (lane & 3);
    const unsigned gr = (unsigned)__builtin_amdgcn_ds_bpermute((p & 63) << 2, (int)gpk);
    const float gt = __uint_as_float((gr >> ((g >> 4) << 4)) << 16);
    const float cf = gt * gelu_fast(dj * rs) * (1.0f / PEER_VSCALE);
#pragma unroll
    for (int q = 0; q < 2; ++q) {
        const float c0 = __uint_as_float(__builtin_amdgcn_readlane(__float_as_uint(cf), 2 * q)), c1 = __uint_as_float(__builtin_amdgcn_readlane(__float_as_uint(cf), 2 * q + 1));
        const f32x32 vf = fp6x32(R.v[2 * q], R.v[2 * q + 1]);
        const f32x2 c0v = {c0, c0}, c1v = {c1, c1};
#pragma unroll
        for (int i = 0; i < 16; i += 2) {
            f32x2 av = {acc[i], acc[i + 1]};
            av = __builtin_elementwise_fma(c0v, (f32x2){vf[i], vf[i + 1]}, av); av = __builtin_elementwise_fma(c1v, (f32x2){vf[16 + i], vf[17 + i]}, av);
            acc[i] = av.x; acc[i + 1] = av.y;
        }
    }
}
struct PeerMeta { u32x2 xq[4]; int i0, i1; float g0, g1, sq; };
__device__ __forceinline__ void peer_meta_load(PeerMeta& m, const WS& w, int t, int lane) {
#pragma unroll
    for (int k = 0; k < 4; ++k) m.xq[k] = *(const u32x2*)(w.xb1 + (size_t)t * DM + 256 * k + 4 * lane);
    m.i0 = w.pidx[(size_t)t * 128 + lane]; m.i1 = w.pidx[(size_t)t * 128 + 64 + lane];
    m.g0 = w.pgate[(size_t)t * 128 + lane]; m.g1 = w.pgate[(size_t)t * 128 + 64 + lane];
    m.sq = w.ssqp[(size_t)t * 16 + (lane & 15)];
}
__device__ __forceinline__ void peer_token_body(Rows4& X, Rows4& Y, Rows4& Z, PeerMeta& mn, const WS& w, const unsigned char* __restrict__ U, const unsigned char* __restrict__ V,
                                                const float* __restrict__ fin_g, float* __restrict__ out, int t, int tstep, int lane) {
    float xf[16];
#pragma unroll
    for (int k = 0; k < 4; ++k) { xf[4 * k] = lo_bf(mn.xq[k].x); xf[4 * k + 1] = hi_bf(mn.xq[k].x); xf[4 * k + 2] = lo_bf(mn.xq[k].y); xf[4 * k + 3] = hi_bf(mn.xq[k].y); }
    float rs; { float sq = mn.sq; sq += dppmov<DPP_XOR1>(sq); sq += dppmov<DPP_XOR2>(sq); sq += dppmov<DPP_ROR4>(sq); sq += dppmov<DPP_ROR8>(sq); rs = rsqrtf(sq * (1.0f / DM) + EPS) * (1.0f / PEER_USCALE); }
    const int epk = mn.i0 | (mn.i1 << 16);
    const unsigned gpk = pk2(mn.g0, mn.g1);
    const bool has_next = t + tstep < T;
    if (has_next) peer_meta_load(mn, w, t + tstep, lane);
    float acc[16];
#pragma unroll
    for (int i = 0; i < 16; ++i) acc[i] = 0.f;
    for (int g = 0; g < 30; g += 3) {
        peer_load4(Z, U, V, epk, g + 2, lane);
        peer_compute4(X, acc, xf, rs, gpk, g, lane);
        peer_load4(X, U, V, epk, g + 3, lane);
        peer_compute4(Y, acc, xf, rs, gpk, g + 1, lane);
        peer_load4(Y, U, V, epk, g + 4, lane);
        peer_compute4(Z, acc, xf, rs, gpk, g + 2, lane);
    }
    const int epn = mn.i0 | (mn.i1 << 16);
    if (has_next) peer_load4(Z, U, V, epn, 0, lane);
    peer_compute4(X, acc, xf, rs, gpk, 30, lane);
    if (has_next) peer_load4(X, U, V, epn, 1, lane);
    peer_compute4(Y, acc, xf, rs, gpk, 31, lane);
    float x[16]; float ss = 0.f;
#pragma unroll
    for (int i = 0; i < 16; ++i) { x[i] = xf[i] + acc[i]; ss += x[i] * x[i]; }
    ss = wave_sum(ss);
    const float rn = rsqrtf(ss * (1.0f / DM) + EPS);
    if (out) {
#pragma unroll
        for (int i = 0; i < 4; ++i) {
            const f32x4 ga = *(const f32x4*)(fin_g + 256 * i + 4 * lane);
            f32x4 a = {x[4 * i] * rn * ga[0], x[4 * i + 1] * rn * ga[1], x[4 * i + 2] * rn * ga[2], x[4 * i + 3] * rn * ga[3]};
            *(f32x4*)(out + (size_t)t * DM + 256 * i + 4 * lane) = a;
        }
    } else {
#pragma unroll
        for (int i = 0; i < 4; ++i) { u32x2 wq; wq.x = pk2(x[4 * i], x[4 * i + 1]); wq.y = pk2(x[4 * i + 2], x[4 * i + 3]); *(u32x2*)(w.xb + (size_t)t * DM + 256 * i + 4 * lane) = wq; }
        if (lane == 0) w.rs1[t] = rn;
    }
}
__device__ __forceinline__ void peer_fast_wave(const WS& w, int layer, const float* __restrict__ fin_g, float* __restrict__ out, int t0, int tstep, int lane) {
    const unsigned char* U = w.U8 + (size_t)layer * PE * 768; const unsigned char* V = w.V8 + (size_t)layer * PE * 768;
    if (t0 >= T) return;
    PeerMeta mn; peer_meta_load(mn, w, t0, lane);
    Rows4 A, B, C;
    { const int epk = mn.i0 | (mn.i1 << 16); peer_load4(A, U, V, epk, 0, lane); peer_load4(B, U, V, epk, 1, lane); }
    for (int t = t0; ; ) {
        peer_token_body(A, B, C, mn, w, U, V, fin_g, out, t, tstep, lane); t += tstep; if (t >= T) break;
        peer_token_body(C, A, B, mn, w, U, V, fin_g, out, t, tstep, lane); t += tstep; if (t >= T) break;
        peer_token_body(B, C, A, mn, w, U, V, fin_g, out, t, tstep, lane); t += tstep; if (t >= T) break;
    }
}

typedef float f32x16 __attribute__((ext_vector_type(16)));
__device__ __forceinline__ unsigned umax_(unsigned a, unsigned b) { return a > b ? a : b; }
__device__ __forceinline__ unsigned umin_(unsigned a, unsigned b) { return a < b ? a : b; }
__device__ __forceinline__ unsigned fkey(float v, unsigned mask, unsigned pay) {
    unsigned u = __float_as_uint(v); u = (u & 0x80000000u) ? ~u : (u | 0x80000000u); return (u & ~mask) | pay; }
__device__ __forceinline__ float fkey_val(unsigned k, unsigned mask) { unsigned v = k & ~mask; v = (v & 0x80000000u) ? (v ^ 0x80000000u) : ~v; return __uint_as_float(v); }
template <int N> __device__ __forceinline__ void bitonic_sort_desc(unsigned (&a)[N]) {
#pragma unroll
    for (int k = 2; k <= N; k <<= 1) {
#pragma unroll
        for (int j = k >> 1; j > 0; j >>= 1) {
#pragma unroll
            for (int i = 0; i < N; ++i) { const int l = i ^ j; if (l > i) { const bool desc = ((i & k) == 0);
                const unsigned hi = umax_(a[i], a[l]), lo = umin_(a[i], a[l]); a[i] = desc ? hi : lo; a[l] = desc ? lo : hi; } }
        }
    }
}
template <int N> __device__ __forceinline__ void bitonic_merge_desc(unsigned (&a)[N]) {
#pragma unroll
    for (int j = N >> 1; j > 0; j >>= 1) {
#pragma unroll
        for (int i = 0; i < N; ++i) { const int l = i ^ j; if (l > i) { const unsigned hi = umax_(a[i], a[l]), lo = umin_(a[i], a[l]); a[i] = hi; a[l] = lo; } }
    }
}
__device__ __forceinline__ void top16_merge(unsigned (&a)[16], const unsigned (&b)[16]) {
#pragma unroll
    for (int i = 0; i < 16; ++i) a[i] = umax_(a[i], b[15 - i]);
    bitonic_merge_desc<16>(a);
}
__device__ __forceinline__ void top16_xlane(unsigned (&a)[16], int hh) {
    unsigned p[16];
#pragma unroll
    for (int i = 0; i < 16; ++i) { const auto r = __builtin_amdgcn_permlane32_swap(a[i], a[i], false, false); p[i] = hh ? r[0] : r[1]; }
    top16_merge(a, p);
}
constexpr int RT_SKP = 272;
constexpr int RT_SK_BYTES = 256 * RT_SKP;
__device__ __forceinline__ void route_scores_top16(unsigned (&g0)[16], const WS& w, const LAS unsigned char* skl, int t, int h, int c, int col, int hh) {
    asm volatile("" : "+v"(hh));
    {
        f32x16 acc[4];
#pragma unroll
        for (int kt = 0; kt < 4; ++kt)
#pragma unroll
            for (int r = 0; r < 16; ++r) acc[kt][r] = 0.f;
        const bf16_t* qrow = w.q + (size_t)t * 2048 + h * PQD + c * PHALF + 8 * hh;
        const LAS unsigned char* sk = skl + (c * PK + col) * RT_SKP + 16 * hh;
#pragma unroll
        for (int ks = 0; ks < 8; ++ks) {
            const bf16x8 b = *(const bf16x8*)(qrow + 16 * ks);
#pragma unroll
            for (int kt = 0; kt < 4; ++kt) {
                const bf16x8 a = *(const LAS bf16x8*)(sk + kt * 32 * RT_SKP + 32 * ks);
                acc[kt] = __builtin_amdgcn_mfma_f32_32x32x16_bf16(a, b, acc[kt], 0, 0, 0);
            }
        }
        unsigned g1[16], g2[16], g3[16];
#pragma unroll
        for (int r = 0; r < 16; ++r) {
            const unsigned kb = 8 * (r >> 2) + 4 * hh + (r & 3);
            g0[r] = fkey(acc[0][r], 0x7Fu, 127u - kb); g1[r] = fkey(acc[1][r], 0x7Fu, 127u - (32u + kb));
            g2[r] = fkey(acc[2][r], 0x7Fu, 127u - (64u + kb)); g3[r] = fkey(acc[3][r], 0x7Fu, 127u - (96u + kb));
        }
        bitonic_sort_desc<16>(g0); bitonic_sort_desc<16>(g1); bitonic_sort_desc<16>(g2); bitonic_sort_desc<16>(g3);
        top16_merge(g0, g1); top16_merge(g2, g3); top16_merge(g0, g2);
        top16_xlane(g0, hh);
    }
}
__device__ __forceinline__ void route_fast_unit(const WS& w, const LAS unsigned char* skl, int tb, int h, int lane, volatile __attribute__((address_space(3))) unsigned* ldsw) {
    const int col = lane & 31, hh = lane >> 5;
    const int t = tb * 32 + col;
    unsigned top0[16], top1[16];
    route_scores_top16(top0, w, skl, t, h, 0, col, hh);
    route_scores_top16(top1, w, skl, t, h, 1, col, hh);
    float v0[16], v1[16];
#pragma unroll
    for (int i = 0; i < 16; ++i) { v0[i] = fkey_val(top0[i], 0x7Fu); v1[i] = fkey_val(top1[i], 0x7Fu); }
    unsigned ca[16], cb[16];
#pragma unroll
    for (int i = 0; i < 16; ++i) { ca[i] = 0u; cb[i] = 0u; }
#define CAND(s, a0, b0, a1, b1) { const float sv = hh ? (v0[a1] + v1[b1]) : (v0[a0] + v1[b0]); const unsigned pay = 255u - (unsigned)(hh ? (a1 * 16 + b1) : (a0 * 16 + b0)); \
        if ((s) < 16) ca[(s) & 15] = fkey(sv, 0xFFu, pay); else cb[(s) & 15] = fkey(sv, 0xFFu, pay); }
    CAND(0, 0, 0, 0, 1); CAND(1, 0, 2, 0, 3); CAND(2, 0, 4, 0, 5); CAND(3, 0, 6, 0, 7); CAND(4, 0, 8, 0, 9); CAND(5, 0, 10, 0, 11); CAND(6, 0, 12, 0, 13); CAND(7, 0, 14, 0, 15);
    CAND(8, 1, 0, 1, 1); CAND(9, 1, 2, 1, 3); CAND(10, 1, 4, 1, 5); CAND(11, 1, 6, 1, 7); CAND(12, 2, 0, 2, 1); CAND(13, 2, 2, 2, 3); CAND(14, 2, 4, 3, 0); CAND(15, 3, 1, 3, 2);
    CAND(16, 3, 3, 4, 0); CAND(17, 4, 1, 4, 2); CAND(18, 5, 0, 5, 1); CAND(19, 6, 0, 6, 1); CAND(20, 7, 0, 7, 1); CAND(21, 8, 0, 9, 0); CAND(22, 10, 0, 11, 0); CAND(23, 12, 0, 13, 0); CAND(24, 14, 0, 15, 0);
#undef CAND
    bitonic_sort_desc<16>(ca); bitonic_sort_desc<16>(cb);
    top16_merge(ca, cb);
    top16_xlane(ca, hh);
    volatile __attribute__((address_space(3))) unsigned* mine = ldsw + lane * 9;
#pragma unroll
    for (int j = 0; j < 4; ++j) {
        mine[j] = (127u - (top0[4 * j] & 127u)) | ((127u - (top0[4 * j + 1] & 127u)) << 8) | ((127u - (top0[4 * j + 2] & 127u)) << 16) | ((127u - (top0[4 * j + 3] & 127u)) << 24);
        mine[4 + j] = (127u - (top1[4 * j] & 127u)) | ((127u - (top1[4 * j + 1] & 127u)) << 8) | ((127u - (top1[4 * j + 2] & 127u)) << 16) | ((127u - (top1[4 * j + 3] & 127u)) << 24);
    }
    volatile __attribute__((address_space(3))) unsigned char* tb8 = (volatile __attribute__((address_space(3))) unsigned char*)mine;
    int ex[16]; float ev[16];
    const float vmax = fkey_val(ca[0], 0xFFu);
    float esum = 0.f;
#pragma unroll
    for (int r = 0; r < 16; ++r) {
        const unsigned pay = 255u - (ca[r] & 255u);
        const int ia = tb8[pay >> 4], ib = tb8[16 + (pay & 15u)];
        ex[r] = ia * PK + ib;
        ev[r] = __builtin_amdgcn_exp2f((fkey_val(ca[r], 0xFFu) - vmax) * 1.4426950408889634f);
        esum += ev[r];
    }
    const float inv = 1.0f / esum;
    int* pi = w.pidx + (size_t)t * 128 + h * PTOP + 8 * hh; float* pg = w.pgate + (size_t)t * 128 + h * PTOP + 8 * hh;
    typedef int i32x4 __attribute__((ext_vector_type(4)));
    i32x4 i0, i1; f32x4 gg0, gg1;
#pragma unroll
    for (int j = 0; j < 4; ++j) {
        int ea = ex[j], eb = ex[8 + j], ec = ex[4 + j], ed = ex[12 + j]; float fa = ev[j], fb = ev[8 + j], fc = ev[4 + j], fd = ev[12 + j];
        asm volatile("" : "+v"(ea), "+v"(eb), "+v"(ec), "+v"(ed), "+v"(fa), "+v"(fb), "+v"(fc), "+v"(fd));
        i0[j] = hh ? eb : ea; i1[j] = hh ? ed : ec; gg0[j] = (hh ? fb : fa) * inv; gg1[j] = (hh ? fd : fc) * inv; }
    *(i32x4*)pi = i0; *(i32x4*)(pi + 4) = i1; *(f32x4*)pg = gg0; *(f32x4*)(pg + 4) = gg1;
}


constexpr int AT_KP = 144, AT_VP = 136, AT_KBYTES = 64 * AT_KP, AT_BUF = 64 * AT_KP + 64 * AT_VP;
typedef unsigned short LAS lds_bf16;
__device__ __forceinline__ float vmax3(float a, float b, float c) { return fmaxf(fmaxf(a, b), c); }
struct AttnOut { bf16_t* cat; bf16_t* dilO; float* dilL; const float* subg; float lam, lam_init; int layer; };
template <int MODE, bool RES = false, bool DUAL = false>
__device__ __forceinline__ void attn_unit(LAS unsigned char* lds, const bf16_t* __restrict__ proj, int qcol, int kcol, int vcol, int rowbase_a, int rstep,
                                          int i0, int nq, int kstart, int ntiles, int W, const AttnOut& ao, int ocol, int tid, int rowbase2 = 0) {
    constexpr int NM = (MODE == 0) ? 2 : 1;
    const int lane = tid & 63, wv = __builtin_amdgcn_readfirstlane(tid >> 6), col = lane & 31, hh = lane >> 5;
    const int wq = DUAL ? (wv & 3) : wv, jlo = (DUAL && wv >= 4) ? 2 : 0, rowbase = (DUAL && wv >= 4) ? rowbase2 : rowbase_a;
    const int a0 = i0 + 32 * wq; const bool active = (32 * wq < nq);
    const int qi = a0 + col;
    const float sl2 = ((MODE == 0) ? 0.17677669529663687f : 0.125f) * 1.4426950408889634f;
    bf16x8 qf[4];
    { const bf16_t* qp = proj + (size_t)(rowbase + rstep * (active ? qi : i0)) * INW + qcol + 8 * hh;
#pragma unroll
      for (int ks = 0; ks < 4; ++ks) qf[ks] = *(const bf16x8*)(qp + 16 * ks); }
    f32x16 O[NM][2]; float mrun[NM], lsum[NM];
#pragma unroll
    for (int m = 0; m < NM; ++m) { mrun[m] = -1e30f; lsum[m] = 0.f;
#pragma unroll
        for (int mt = 0; mt < 2; ++mt)
#pragma unroll
            for (int r = 0; r < 16; ++r) O[m][mt][r] = 0.f; }
    const int srow = tid >> 3, spiece = tid & 7;
    u32x4 kreg, vreg;
#define AT_LOAD(j) do { const bf16_t* rp = proj + (size_t)(rowbase_a + rstep * (kstart + 64 * (j) + srow)) * INW + 8 * spiece; \
        kreg = *(const u32x4*)(rp + kcol); vreg = *(const u32x4*)(rp + vcol); } while (0)
#define AT_WRITE(buf) do { LAS unsigned char* B_ = lds + (buf) * AT_BUF; *(LAS u32x4*)(B_ + srow * AT_KP + spiece * 16) = kreg; \
        lds_bf16* vt_ = (lds_bf16*)(B_ + AT_KBYTES) + (8 * spiece) * (AT_VP / 2) + srow; \
        vt_[0 * (AT_VP / 2)] = (bf16_t)(vreg.x & 0xffffu); vt_[1 * (AT_VP / 2)] = (bf16_t)(vreg.x >> 16); vt_[2 * (AT_VP / 2)] = (bf16_t)(vreg.y & 0xffffu); vt_[3 * (AT_VP / 2)] = (bf16_t)(vreg.y >> 16); \
        vt_[4 * (AT_VP / 2)] = (bf16_t)(vreg.z & 0xffffu); vt_[5 * (AT_VP / 2)] = (bf16_t)(vreg.z >> 16); vt_[6 * (AT_VP / 2)] = (bf16_t)(vreg.w & 0xffffu); vt_[7 * (AT_VP / 2)] = (bf16_t)(vreg.w >> 16); } while (0)
    if (RES) {
        u32x4 kr[6], vr[6];
#pragma unroll
        for (int j = 0; j < 6; ++j) if (j < ntiles) { const int rb_ = (DUAL && j >= 2) ? rowbase2 : rowbase_a, kt_ = DUAL ? (j & 1) : j;
            const bf16_t* rp = proj + (size_t)(rb_ + rstep * (kstart + 64 * kt_ + srow)) * INW + 8 * spiece; kr[j] = *(const u32x4*)(rp + kcol); vr[j] = *(const u32x4*)(rp + vcol); }
#pragma unroll
        for (int j = 0; j < 6; ++j) if (j < ntiles) { kreg = kr[j]; vreg = vr[j]; AT_WRITE(j); }
    } else { AT_LOAD(0); AT_WRITE(0); }
    __syncthreads();
    for (int j = jlo; j < (DUAL ? jlo + 2 : ntiles); ++j) {
        if (!RES && j + 1 < ntiles) AT_LOAD(j + 1);
        const LAS unsigned char* Kb = lds + (RES ? j : (j & 1)) * AT_BUF; const LAS unsigned char* Vb = Kb + AT_KBYTES;
        const int k0 = kstart + 64 * (DUAL ? (j - jlo) : j);
#pragma unroll
        for (int sb = 0; sb < 2; ++sb) {
            const int ks0 = k0 + 32 * sb;
            if (active && ks0 <= a0 + 31 && ks0 + 31 >= a0 - W) {
#pragma unroll
                for (int m = 0; m < NM; ++m) {
                    f32x16 s;
#pragma unroll
                    for (int r = 0; r < 16; ++r) s[r] = 0.f;
#pragma unroll
                    for (int ks = 0; ks < 4 / NM; ++ks) {
                        const int kq = (MODE == 0) ? (2 * m + ks) : ks;
                        const bf16x8 af = *(const LAS bf16x8*)(Kb + (32 * sb + col) * AT_KP + (16 * kq + 8 * hh) * 2);
                        s = __builtin_amdgcn_mfma_f32_32x32x16_bf16(af, qf[kq], s, 0, 0, 0);
                    }
                    const bool masked = (ks0 + 31 > a0) || (ks0 < a0 + 31 - W);
                    if (masked) {
                        const int dq = qi - ks0 - 4 * hh;
#pragma unroll
                        for (int r = 0; r < 16; ++r) {
                            const int off = 8 * (r >> 2) + (r & 3);
                            const bool valid = (off <= dq) && (off >= dq - W);
                            s[r] = valid ? s[r] : -1e30f;
                        }
                    }
                    float mx = vmax3(s[0], s[1], s[2]);
                    mx = vmax3(mx, s[3], s[4]); mx = vmax3(mx, s[5], s[6]); mx = vmax3(mx, s[7], s[8]); mx = vmax3(mx, s[9], s[10]);
                    mx = vmax3(mx, s[11], s[12]); mx = vmax3(mx, s[13], s[14]); mx = fmaxf(mx, s[15]);
                    { const auto sw = __builtin_amdgcn_permlane32_swap(__float_as_uint(mx), __float_as_uint(mx), false, false);
                      mx = fmaxf(__uint_as_float(sw[0]), __uint_as_float(sw[1])); }
                    mx = (mx > -1e29f) ? mx * sl2 : -1e30f;
                    if (__any(mx > mrun[m])) {
                        const float mnew = (mx > mrun[m]) ? mx : mrun[m], alpha = __builtin_amdgcn_exp2f(mrun[m] - mnew);
                        mrun[m] = mnew; lsum[m] *= alpha;
#pragma unroll
                        for (int mt = 0; mt < 2; ++mt)
#pragma unroll
                            for (int r = 0; r < 16; ++r) O[m][mt][r] *= alpha;
                    }
                    {
                        const f32x2 sl2v = {sl2, sl2}, mnegv = {-mrun[m], -mrun[m]};
                        f32x2 ps = {0.f, 0.f};
                        if (masked) {
#pragma unroll
                            for (int r = 0; r < 16; r += 2) {
                                const f32x2 a2 = (f32x2){s[r], s[r + 1]} * sl2v + mnegv;
                                const float p0 = (s[r] > -1e29f) ? __builtin_amdgcn_exp2f(a2.x) : 0.f, p1 = (s[r + 1] > -1e29f) ? __builtin_amdgcn_exp2f(a2.y) : 0.f;
                                s[r] = p0; s[r + 1] = p1; ps += (f32x2){p0, p1};
                            }
                        } else {
#pragma unroll
                            for (int r = 0; r < 16; r += 2) {
                                const f32x2 a2 = (f32x2){s[r], s[r + 1]} * sl2v + mnegv;
                                const float p0 = __builtin_amdgcn_exp2f(a2.x), p1 = __builtin_amdgcn_exp2f(a2.y);
                                s[r] = p0; s[r + 1] = p1; ps += (f32x2){p0, p1};
                            }
                        }
                        lsum[m] += ps.x + ps.y;
                    }
#pragma unroll
                    for (int st = 0; st < 2; ++st) {
                        u32x4 pw; pw.x = pk2(s[8 * st], s[8 * st + 1]); pw.y = pk2(s[8 * st + 2], s[8 * st + 3]); pw.z = pk2(s[8 * st + 4], s[8 * st + 5]); pw.w = pk2(s[8 * st + 6], s[8 * st + 7]);
                        const bf16x8 pf = __builtin_bit_cast(bf16x8, pw);
#pragma unroll
                        for (int mt = 0; mt < 2; ++mt) {
                            const LAS unsigned char* vp = Vb + (32 * mt + col) * AT_VP + (32 * sb + 16 * st + 4 * hh) * 2;
                            const u32x2 lo = *(const LAS u32x2*)vp, hi = *(const LAS u32x2*)(vp + 16);
                            u32x4 vw; vw.x = lo.x; vw.y = lo.y; vw.z = hi.x; vw.w = hi.y;
                            O[m][mt] = __builtin_amdgcn_mfma_f32_32x32x16_bf16(__builtin_bit_cast(bf16x8, vw), pf, O[m][mt], 0, 0, 0);
                        }
                    }
                }
            }
        }
        if (!RES) { if (j + 1 < ntiles) AT_WRITE((j + 1) & 1); __syncthreads(); }
    }
    if (RES) __syncthreads();
#undef AT_LOAD
#undef AT_WRITE
    if (active) {
        const size_t row = (size_t)(rowbase + rstep * qi);
        if (MODE == 0) {
            const float l0 = lsum[0] + __shfl_xor(lsum[0], 32), l1 = lsum[NM - 1] + __shfl_xor(lsum[NM - 1], 32);
            const float i0v = 1.0f / l0, i1v = ao.lam / l1;
            float ss = 0.f;
#pragma unroll
            for (int mt = 0; mt < 2; ++mt)
#pragma unroll
                for (int r = 0; r < 16; ++r) { const float o = O[0][mt][r] * i0v - O[NM - 1][mt][r] * i1v; O[0][mt][r] = o; ss += o * o; }
            ss += __shfl_xor(ss, 32);
            const float rn = rsqrtf(ss * (1.0f / 64.0f) + EPS) * (1.0f - ao.lam_init);
#pragma unroll
            for (int mt = 0; mt < 2; ++mt)
#pragma unroll
                for (int g = 0; g < 4; ++g) {
                    const int d0 = 32 * mt + 8 * g + 4 * hh;
                    const f32x4 sg = *(const f32x4*)(ao.subg + ao.layer * 64 + d0);
                    u32x2 wv2; wv2.x = pk2(O[0][mt][4 * g] * rn * sg[0], O[0][mt][4 * g + 1] * rn * sg[1]); wv2.y = pk2(O[0][mt][4 * g + 2] * rn * sg[2], O[0][mt][4 * g + 3] * rn * sg[3]);
                    *(u32x2*)(ao.cat + row * DM + ocol + d0) = wv2;
                }
        } else {
            const float l0 = lsum[0] + __shfl_xor(lsum[0], 32), inv = 1.0f / l0;
#pragma unroll
            for (int mt = 0; mt < 2; ++mt)
#pragma unroll
                for (int g = 0; g < 4; ++g) {
                    const int d0 = 32 * mt + 8 * g + 4 * hh;
                    u32x2 wv2; wv2.x = pk2(O[0][mt][4 * g] * inv, O[0][mt][4 * g + 1] * inv); wv2.y = pk2(O[0][mt][4 * g + 2] * inv, O[0][mt][4 * g + 3] * inv);
                    *(u32x2*)(ao.dilO + row * DILW + ocol + d0) = wv2;
                }
            if (hh == 0) ao.dilL[row * DILH + (ocol >> 6)] = (mrun[0] + __builtin_amdgcn_logf(l0)) * 0.6931471805599453f;
        }
    }
}
constexpr int N_ATTN_UNITS = 1408;
constexpr int A_DEFER = 3;
__device__ __forceinline__ void attn_dispatch(LAS unsigned char* lds, const WS& w, int u, AttnOut ao, int tid) {
    if (u < 256) {
        const int qb = 7 - (u >> 5), bh = u & 31, b = bh >> 2, h = bh & 3;
        attn_unit<0>(lds, w.proj, OFF_FQ + h * 64, OFF_FK + h * 64, OFF_FV + h * 64, b * SEQ, 1, 256 * qb, 256, 0, 4 * (qb + 1), 1 << 30, ao, 768 + h * 64, tid);
    } else if (u < 640) {
        const int v = u - 256, qb = 7 - v / 48, bh = v % 48, b = bh / 6, hd = bh % 6;
        const int i0 = 256 * qb, ks = (i0 >= 128) ? i0 - 128 : 0;
        ao.dilO = w.dilO; ao.dilL = w.dilL;
        attn_unit<1, true>(lds, w.proj, OFF_DQ + hd * 64, OFF_DK + hd * 64, OFF_DV + hd * 64, b * SEQ, 1, i0, 256, ks, (i0 + 256 - ks) / 64, 128, ao, hd * 64, tid);
    } else if (u < 1024) {
        const int v = u - 640, qb = 1 - v / 192, rr = (v % 192) / 48, bh = v % 48, b = bh / 6, hd = bh % 6;
        const int i0 = 256 * qb, ks = (i0 >= 128) ? i0 - 128 : 0;
        ao.dilO = w.dilO + (size_t)T * DILW; ao.dilL = w.dilL + (size_t)T * DILH;
        attn_unit<1, true>(lds, w.proj, OFF_DQ + hd * 64, OFF_DK + hd * 64, OFF_DV + hd * 64, b * SEQ + rr, 4, i0, 256, ks, (i0 + 256 - ks) / 64, 128, ao, hd * 64, tid);
    } else {
        const int v = u - 1024, rr = v / 48, bh = v % 48, b = bh / 6, hd = bh % 6;
        ao.dilO = w.dilO + (size_t)2 * T * DILW; ao.dilL = w.dilL + (size_t)2 * T * DILH;
        attn_unit<1, true, true>(lds, w.proj, OFF_DQ + hd * 64, OFF_DK + hd * 64, OFF_DV + hd * 64, b * SEQ + rr, 16, 0, 128, 0, 4, 128, ao, hd * 64, tid, b * SEQ + rr + 8);
    }
}


constexpr int S5_KT = 64 * 256, S5_W = 64 * 128 * 16;
struct S5Tab { bf16_t *Ktab, *Wend, *Wout; const float *lam_re, *lam_im, *log_step; };
constexpr int NTHR_C = 512;
__device__ __forceinline__ f32x2 cmul(f32x2 a, f32x2 b) { return (f32x2){a.x * b.x - a.y * b.y, a.x * b.y + a.y * b.x}; }
__device__ __forceinline__ void s5_prep_task(LAS unsigned char* lds, const S5Tab& st, const float* __restrict__ lam_re, const float* __restrict__ lam_im, const float* __restrict__ log_step,
                                             const float* __restrict__ b_re, const float* __restrict__ b_im, const float* __restrict__ c_re, const float* __restrict__ c_im,
                                             const float* __restrict__ dsk, int lg, int oct, int tid) {
    LAS f32x2* PwL = (LAS f32x2*)lds;
    LAS f32x2* BbL = PwL + 9 * 64;
    LAS f32x2* CL = BbL + 64 * 16;
    const float dt = expf(log_step[lg]);
    for (int i = tid; i < 9 * 64; i += NTHR_C) {
        const int p = i & 63; const float n = (float)(8 * oct + (i >> 6));
        const float lr = lam_re[(size_t)lg * NS + p], li = lam_im[(size_t)lg * NS + p];
        const float mag = expf(lr * dt * n), ang = li * dt * n;
        PwL[i] = (f32x2){mag * cosf(ang), mag * sinf(ang)};
    }
    for (int i = tid; i < 64 * 16; i += NTHR_C) {
        const int p = i >> 4; const size_t lgp = (size_t)lg * NS + p;
        const float lr = lam_re[lgp], li = lam_im[lgp];
        const float mag = expf(lr * dt), lbr = mag * cosf(li * dt), lbi = mag * sinf(li * dt);
        const float nr = lbr - 1.0f, ni = lbi, den = lr * lr + li * li;
        const f32x2 kap = {(nr * lr + ni * li) / den, (ni * lr - nr * li) / den};
        BbL[i] = cmul(kap, (f32x2){b_re[(size_t)lg * NS * GC + i], b_im[(size_t)lg * NS * GC + i]});
        CL[i] = (f32x2){c_re[(size_t)lg * GC * NS + i], c_im[(size_t)lg * GC * NS + i]};
    }
    __syncthreads();
    {
        const int ci = tid & 15, co = (tid >> 4) & 15, jj0 = tid >> 8;
        float s[4] = {0.f, 0.f, 0.f, 0.f};
        for (int p = 0; p < NS; ++p) {
            const f32x2 bb = BbL[p * 16 + ci], cc = CL[co * 64 + p];
#pragma unroll
            for (int q = 0; q < 4; ++q) { const f32x2 m = cmul(PwL[(jj0 + 2 * q) * 64 + p], bb); s[q] += cc.x * m.x - cc.y * m.y; }
        }
#pragma unroll
        for (int q = 0; q < 4; ++q) {
            const int j = 8 * oct + jj0 + 2 * q;
            const float v = s[q] + ((j == 0 && co == ci) ? dsk[(size_t)lg * GC + co] : 0.f);
            st.Ktab[(size_t)lg * S5_KT + (j * 16 + co) * 16 + ci] = f2bf(v);
        }
    }
    for (int i = tid; i < 2048; i += NTHR_C) {
        const int ch = i & 1, rho = (i >> 1) & 127, jj = i >> 8, p = rho & 63, sg = 63 - (8 * oct + jj);
        const f32x2 pw = PwL[jj * 64 + p];
        float v[8];
#pragma unroll
        for (int c = 0; c < 8; ++c) { const f32x2 z = cmul(pw, BbL[p * 16 + 8 * ch + c]); v[c] = (rho < 64) ? z.x : z.y; }
        u32x4 w; w.x = pk2(v[0], v[1]); w.y = pk2(v[2], v[3]); w.z = pk2(v[4], v[5]); w.w = pk2(v[6], v[7]);
        *(u32x4*)(st.Wend + (size_t)lg * S5_W + ((size_t)(sg * 128 + rho) * 16 + 8 * ch)) = w;
    }
    for (int i = tid; i < 2048; i += NTHR_C) {
        const int r8 = i & 15, co = (i >> 4) & 15, jj = i >> 8, tau = 8 * oct + jj;
        float v[8];
#pragma unroll
        for (int e = 0; e < 8; ++e) { const int rho = 8 * r8 + e, p = rho & 63; const f32x2 z = cmul(CL[co * 64 + p], PwL[(jj + 1) * 64 + p]); v[e] = (rho < 64) ? z.x : -z.y; }
        u32x4 w; w.x = pk2(v[0], v[1]); w.y = pk2(v[2], v[3]); w.z = pk2(v[4], v[5]); w.w = pk2(v[6], v[7]);
        *(u32x4*)(st.Wout + (size_t)lg * S5_W + ((size_t)(tau * 16 + co) * 128 + 8 * r8)) = w;
    }
    __syncthreads();
}
constexpr int S5_LDS_U = 0, S5_LDS_K = 65536, S5_LDS_E = 65536 + 32768, S5_LDS_X = 65536 + 32768 + 32768;
__device__ __forceinline__ void s5_unit(LAS unsigned char* lds, const WS& w, const S5Tab& st, int layer, int b, int g, int tid) {
    const int lane = tid & 63, wv = __builtin_amdgcn_readfirstlane(tid >> 6), col = lane & 31, hh = lane >> 5;
    const size_t lg = (size_t)layer * NG + g;
#pragma unroll
    for (int i = 0; i < 8; ++i) {
        const int q = tid + 512 * i, t = q >> 1, half = q & 1;
        const u32x4 v = *(const u32x4*)(w.proj + (size_t)(b * SEQ + t) * INW + g * GC + 8 * half);
        *(LAS u32x4*)(lds + S5_LDS_U + (((t & 63) * 32 + (t >> 6)) * 16 + 8 * half) * 2) = v;
    }
#pragma unroll
    for (int i = 0; i < 4; ++i) { const int q = tid + 512 * i; *(LAS u32x4*)(lds + S5_LDS_K + q * 16) = *(const u32x4*)(st.Ktab + lg * S5_KT + q * 8); }
    __syncthreads();
    {
        const int mt = wv & 3, sh = wv >> 2;
        f32x16 acc;
#pragma unroll
        for (int r = 0; r < 16; ++r) acc[r] = 0.f;
        const bf16_t* wp = st.Wend + lg * S5_W + (size_t)(32 * mt + col) * 16 + 8 * hh;
#pragma unroll 8
        for (int sg = 32 * sh; sg < 32 * sh + 32; ++sg) {
            const bf16x8 af = *(const bf16x8*)(wp + (size_t)sg * 128 * 16);
            const bf16x8 bfv = *(const LAS bf16x8*)(lds + S5_LDS_U + ((sg * 32 + col) * 16 + 8 * hh) * 2);
            acc = __builtin_amdgcn_mfma_f32_32x32x16_bf16(af, bfv, acc, 0, 0, 0);
        }
        LAS float* E = (LAS float*)(lds + S5_LDS_E);
#pragma unroll
        for (int r = 0; r < 16; ++r) E[(sh * 128 + 32 * mt + 8 * (r >> 2) + 4 * hh + (r & 3)) * 32 + col] = acc[r];
    }
    __syncthreads();
    if (tid < NS) {
        const int p = tid;
        f32x2 l64; { const float dt = expf(st.log_step[lg]) * 64.0f, mag = expf(st.lam_re[lg * NS + p] * dt), ang = st.lam_im[lg * NS + p] * dt; l64 = (f32x2){mag * cosf(ang), mag * sinf(ang)}; }
        const LAS float* E = (const LAS float*)(lds + S5_LDS_E);
        lds_bf16* X = (lds_bf16*)(lds + S5_LDS_X);
        f32x2 x = {0.f, 0.f};
        for (int k = 0; k < 32; ++k) {
            X[((p >> 4) * 32 + k) * 16 + (p & 15)] = f2bf(x.x);
            X[((4 + (p >> 4)) * 32 + k) * 16 + (p & 15)] = f2bf(x.y);
            const f32x2 e = {E[p * 32 + k] + E[(128 + p) * 32 + k], E[(64 + p) * 32 + k] + E[(128 + 64 + p) * 32 + k]};
            x = cmul(l64, x); x.x += e.x; x.y += e.y;
        }
    }
    __syncthreads();
#pragma unroll 1
    for (int q = 0; q < 4; ++q) {
        const int i = (q == 0) ? wv : (q == 1) ? 31 - wv : (q == 2) ? wv + 8 : 23 - wv;
        f32x16 acc;
#pragma unroll
        for (int r = 0; r < 16; ++r) acc[r] = 0.f;
        const int tl = col >> 4, co = col & 15;
        const bf16_t* wo = st.Wout + lg * S5_W + (size_t)((2 * i + tl) * 16 + co) * 128 + 8 * hh;
#pragma unroll
        for (int ks = 0; ks < 8; ++ks) {
            const bf16x8 af = *(const bf16x8*)(wo + 16 * ks);
            const bf16x8 bfv = *(const LAS bf16x8*)(lds + S5_LDS_X + ((ks * 32 + col) * 16 + 8 * hh) * 2);
            acc = __builtin_amdgcn_mfma_f32_32x32x16_bf16(af, bfv, acc, 0, 0, 0);
        }
        for (int sg = 0; sg <= 2 * i + 1; ++sg) {
            const int lag = 2 * i + tl - sg;
            bf16x8 af = *(const LAS bf16x8*)(lds + S5_LDS_K + (((lag < 0 ? 0 : lag) * 16 + co) * 16 + 8 * hh) * 2);
            if (lag < 0) af = (bf16x8){0, 0, 0, 0, 0, 0, 0, 0};
            const bf16x8 bfv = *(const LAS bf16x8*)(lds + S5_LDS_U + ((sg * 32 + col) * 16 + 8 * hh) * 2);
            acc = __builtin_amdgcn_mfma_f32_32x32x16_bf16(af, bfv, acc, 0, 0, 0);
        }
#pragma unroll
        for (int g4 = 0; g4 < 4; ++g4) {
            const int t = 64 * col + 2 * i + (g4 >> 1);
            u32x2 o; o.x = pk2(acc[4 * g4], acc[4 * g4 + 1]); o.y = pk2(acc[4 * g4 + 2], acc[4 * g4 + 3]);
            *(u32x2*)(w.yssm + (size_t)(b * SEQ + t) * SSMW + g * GC + 8 * (g4 & 1) + 4 * hh) = o;
        }
    }
    __syncthreads();
}


constexpr int B2_GP = 784;
constexpr int B2_LDS_G = 0, B2_LDS_R1 = 64 * B2_GP, B2_LDS_R2 = B2_LDS_R1 + 64 * 4 * 4;
__device__ __forceinline__ void b2_combine8(float* o, const bf16_t* __restrict__ dilO, size_t row, int c, float w0, float w1, float w2) {
    const u32x4 a = *(const u32x4*)(dilO + row * DILW + c), b = *(const u32x4*)(dilO + ((size_t)T + row) * DILW + c), d = *(const u32x4*)(dilO + ((size_t)2 * T + row) * DILW + c);
    o[0] = w0 * lo_bf(a.x) + w1 * lo_bf(b.x) + w2 * lo_bf(d.x); o[1] = w0 * hi_bf(a.x) + w1 * hi_bf(b.x) + w2 * hi_bf(d.x);
    o[2] = w0 * lo_bf(a.y) + w1 * lo_bf(b.y) + w2 * lo_bf(d.y); o[3] = w0 * hi_bf(a.y) + w1 * hi_bf(b.y) + w2 * hi_bf(d.y);
    o[4] = w0 * lo_bf(a.z) + w1 * lo_bf(b.z) + w2 * lo_bf(d.z); o[5] = w0 * hi_bf(a.z) + w1 * hi_bf(b.z) + w2 * hi_bf(d.z);
    o[6] = w0 * lo_bf(a.w) + w1 * lo_bf(b.w) + w2 * lo_bf(d.w); o[7] = w0 * hi_bf(a.w) + w1 * hi_bf(b.w) + w2 * hi_bf(d.w);
}
__device__ __forceinline__ void b2_fast_unit(LAS unsigned char* lds, const WS& w, int layer, const float* __restrict__ ssm_g, const float* __restrict__ dil_g, int tok0, int tid) {
    const int lane = tid & 63, wv = __builtin_amdgcn_readfirstlane(tid >> 6), col = lane & 31, hh = lane >> 5;
    { const int tk = tid >> 3, c0 = (tid & 7) * 48;
#pragma unroll
      for (int i = 0; i < 6; ++i) {
          const u32x4 v = *(const u32x4*)(w.yssm + (size_t)(tok0 + tk) * SSMW + c0 + 8 * i);
          u32x4 o; o.x = pk2(gelu_fast(lo_bf(v.x)), gelu_fast(hi_bf(v.x))); o.y = pk2(gelu_fast(lo_bf(v.y)), gelu_fast(hi_bf(v.y)));
          o.z = pk2(gelu_fast(lo_bf(v.z)), gelu_fast(hi_bf(v.z))); o.w = pk2(gelu_fast(lo_bf(v.w)), gelu_fast(hi_bf(v.w)));
          *(LAS u32x4*)(lds + B2_LDS_G + tk * B2_GP + (c0 + 8 * i) * 2) = o;
      } }
    float dw0 = 0.f, dw1 = 0.f, dw2 = 0.f; const int dtk = tid / 6, dhd = tid - 6 * dtk;
    unsigned dpk[32];
    if (tid < 384) {
        const size_t row = (size_t)tok0 + dtk;
        const float l0 = w.dilL[row * DILH + dhd], l1 = w.dilL[((size_t)T + row) * DILH + dhd], l2 = w.dilL[((size_t)2 * T + row) * DILH + dhd];
        const float mx = fmaxf(l0, fmaxf(l1, l2)); dw0 = __expf(l0 - mx); dw1 = __expf(l1 - mx); dw2 = __expf(l2 - mx);
        const float inv = 1.0f / (dw0 + dw1 + dw2); dw0 *= inv; dw1 *= inv; dw2 *= inv;
        float ss = 0.f;
#pragma unroll
        for (int i = 0; i < 8; ++i) { float o[8]; b2_combine8(o, w.dilO, row, dhd * 64 + 8 * i, dw0, dw1, dw2);
#pragma unroll
            for (int e = 0; e < 8; ++e) ss += o[e] * o[e];
            dpk[4 * i] = pk2(o[0], o[1]); dpk[4 * i + 1] = pk2(o[2], o[3]); dpk[4 * i + 2] = pk2(o[4], o[5]); dpk[4 * i + 3] = pk2(o[6], o[7]); }
        ((LAS float*)(lds + B2_LDS_R2))[dtk * 8 + dhd] = ss;
    }
    __syncthreads();
    const int tt = wv & 1, cg = wv >> 1;
    f32x16 acc[3];
#pragma unroll
    for (int nt = 0; nt < 3; ++nt)
#pragma unroll
        for (int r = 0; r < 16; ++r) acc[nt][r] = 0.f;
    const bf16_t* wg = w.WgluT + ((size_t)layer * SSMW + 96 * cg + col) * SSMW + 8 * hh;
    const LAS unsigned char* gb = lds + B2_LDS_G + (32 * tt + col) * B2_GP + 16 * hh;
#pragma unroll 8
    for (int ks = 0; ks < 24; ++ks) {
        const bf16x8 bfv = *(const LAS bf16x8*)(gb + 32 * ks);
#pragma unroll
        for (int nt = 0; nt < 3; ++nt) {
            const bf16x8 af = *(const bf16x8*)(wg + (size_t)(32 * nt) * SSMW + 16 * ks);
            acc[nt] = __builtin_amdgcn_mfma_f32_32x32x16_bf16(af, bfv, acc[nt], 0, 0, 0);
        }
    }
    float ss = 0.f;
#pragma unroll
    for (int nt = 0; nt < 3; ++nt)
#pragma unroll
        for (int g4 = 0; g4 < 4; ++g4) {
            const int n0 = 96 * cg + 32 * nt + 8 * g4 + 4 * hh;
            const u32x2 gv = *(const LAS u32x2*)(lds + B2_LDS_G + (32 * tt + col) * B2_GP + n0 * 2);
            const float g0 = lo_bf(gv.x), g1 = hi_bf(gv.x), g2 = lo_bf(gv.y), g3 = hi_bf(gv.y);
            const float y0 = g0 * __builtin_amdgcn_rcpf(1.0f + __builtin_amdgcn_exp2f(-1.4426950408889634f * acc[nt][4 * g4])), y1 = g1 * __builtin_amdgcn_rcpf(1.0f + __builtin_amdgcn_exp2f(-1.4426950408889634f * acc[nt][4 * g4 + 1]));
            const float y2 = g2 * __builtin_amdgcn_rcpf(1.0f + __builtin_amdgcn_exp2f(-1.4426950408889634f * acc[nt][4 * g4 + 2])), y3 = g3 * __builtin_amdgcn_rcpf(1.0f + __builtin_amdgcn_exp2f(-1.4426950408889634f * acc[nt][4 * g4 + 3]));
            acc[nt][4 * g4] = y0; acc[nt][4 * g4 + 1] = y1; acc[nt][4 * g4 + 2] = y2; acc[nt][4 * g4 + 3] = y3;
            ss += (y0 * y0 + y1 * y1) + (y2 * y2 + y3 * y3);
        }
    ss += __shfl_xor(ss, 32);
    if (hh == 0) ((LAS float*)(lds + B2_LDS_R1))[(32 * tt + col) * 4 + cg] = ss;
    __syncthreads();
    {
        const LAS float* r1 = (const LAS float*)(lds + B2_LDS_R1) + (32 * tt + col) * 4;
        const float rn = rsqrtf(((r1[0] + r1[1]) + (r1[2] + r1[3])) * (1.0f / SSMW) + EPS);
        bf16_t* cr = w.cat + (size_t)(tok0 + 32 * tt + col) * DM;
#pragma unroll
        for (int nt = 0; nt < 3; ++nt)
#pragma unroll
            for (int g4 = 0; g4 < 4; ++g4) {
                const int n0 = 96 * cg + 32 * nt + 8 * g4 + 4 * hh;
                const f32x4 sg = *(const f32x4*)(ssm_g + layer * SSMW + n0);
                u32x2 o; o.x = pk2(acc[nt][4 * g4] * rn * sg[0], acc[nt][4 * g4 + 1] * rn * sg[1]); o.y = pk2(acc[nt][4 * g4 + 2] * rn * sg[2], acc[nt][4 * g4 + 3] * rn * sg[3]);
                *(u32x2*)(cr + n0) = o;
            }
    }
    if (tid < 384) {
        const size_t row = (size_t)tok0 + dtk;
        const LAS float* r2 = (const LAS float*)(lds + B2_LDS_R2) + dtk * 8;
        const float rn = rsqrtf((((r2[0] + r2[1]) + (r2[2] + r2[3])) + (r2[4] + r2[5])) * (1.0f / DILW) + EPS);
#pragma unroll
        for (int i = 0; i < 8; ++i) {
            float o[8];
#pragma unroll
            for (int e = 0; e < 4; ++e) { o[2 * e] = lo_bf(dpk[4 * i + e]); o[2 * e + 1] = hi_bf(dpk[4 * i + e]); }
            const f32x4 ga = *(const f32x4*)(dil_g + layer * DILW + dhd * 64 + 8 * i), gb2 = *(const f32x4*)(dil_g + layer * DILW + dhd * 64 + 8 * i + 4);
            u32x4 q; q.x = pk2(o[0] * rn * ga[0], o[1] * rn * ga[1]); q.y = pk2(o[2] * rn * ga[2], o[3] * rn * ga[3]); q.z = pk2(o[4] * rn * gb2[0], o[5] * rn * gb2[1]); q.w = pk2(o[6] * rn * gb2[2], o[7] * rn * gb2[3]);
            *(u32x4*)(w.cat + row * DM + SSMW + dhd * 64 + 8 * i) = q;
        }
    }
    __syncthreads();
}

namespace pg8 {
#define PG8_LAS __attribute__((address_space(3)))
typedef unsigned short bf16_t;
typedef short bf16x8 __attribute__((ext_vector_type(8)));
typedef float f32x4 __attribute__((ext_vector_type(4)));
typedef unsigned u32x4 __attribute__((ext_vector_type(4)));
constexpr int BM = 256, BK = 64, HALF = 128, HTB = HALF * BK * 2  , STAGE_BYTES = 8 * HTB, NXCD = 8, WGM = 8;

__host__ __device__ __forceinline__ int lds_byte(int r, int c) { const int st = (r >> 4) * 2 + (c >> 5), rr = r & 15, cc = c & 31, ob = rr * 64 + cc * 2; return st * 1024 + (ob ^ (((ob >> 9) & 1) << 5)); }
__host__ __device__ __forceinline__ void stage_rc(int b, int& R, int& C) { const int st = b / 1024, sb = b % 1024, swz = sb ^ (((sb >> 9) & 1) << 5); R = (st >> 1) * 16 + swz / 64; C = (st & 1) * 32 + (swz % 64) / 2; }
__host__ __device__ __forceinline__ int perm32(int rho) { const int n = rho >> 4, i = rho & 15; return 8 * (i >> 2) + 4 * n + (i & 3); }

struct Unit { int pm, pn; };
struct Gemm { const bf16_t* A; const bf16_t* Bt; int M, N, K; };

struct StaticOrder {
    int nM, nN, nwg, G, c;
    __host__ __device__ void init(int M, int N, int G_, int c_) { nM = M / BM; nN = N / BM; nwg = nM * nN; G = G_; c = c_; }
    __host__ __device__ bool next(int i, Unit& u) const {
        const long L = (long)i * G + c; if (L >= nwg) return false;
        int wgid = (int)L; { const int q = nwg / NXCD, r = nwg % NXCD, xcd = wgid % NXCD, off = wgid / NXCD; wgid = (xcd < r ? xcd * (q + 1) : r * (q + 1) + (xcd - r) * q) + off; }
        const int nig = WGM * nN, gid = wgid / nig, fm = gid * WGM, gsz = (nM - fm) < WGM ? (nM - fm) : WGM;
        u.pm = fm + ((wgid % nig) % gsz); u.pn = (wgid % nig) / gsz; return true;
    }
    __device__ __forceinline__ void a_ready(const Unit&) const {}
    __device__ __forceinline__ void done(const Unit&) const {}
};
struct SkipOrder {
    StaticOrder so; int skip;
    __device__ __forceinline__ bool next(int i, Unit& u) const { if (!so.next(i, u)) return false; u.pn += (u.pn >= skip) ? 1 : 0; return true; }
    __device__ __forceinline__ void a_ready(const Unit&) const {}
    __device__ __forceinline__ void done(const Unit&) const {}
};
struct OneUnit {
    int pm, pn;
    __device__ __forceinline__ bool next(int i, Unit& u) const { if (i) return false; u.pm = pm; u.pn = pn; return true; }
    __device__ __forceinline__ void a_ready(const Unit&) const {}
    __device__ __forceinline__ void done(const Unit&) const {}
};


__device__ __forceinline__ unsigned pk2bf(float a, float b) {
    typedef __bf16 bf2 __attribute__((ext_vector_type(2))); typedef float f2 __attribute__((ext_vector_type(2)));
    f2 v = {a, b}; bf2 r = __builtin_convertvector(v, bf2); return __builtin_bit_cast(unsigned, r);
}
struct EpiScaleBf16 {
    static constexpr bool PERM = true, AFTER_DRAIN = false;
    bf16_t* O; int ldc; const float* rs; const float* ssqp;
    __device__ __forceinline__ void operator()(const f32x4 (&acc)[2][2][4][2], const Unit& u, int wr, int wc, int fr, int fq) const {
        const int row0 = u.pm * BM + wr * 64 + fr, col0 = u.pn * BM + wc * 32 + 8 * fq;
#pragma unroll
        for (int ai = 0; ai < 2; ++ai)
#pragma unroll
            for (int m = 0; m < 4; ++m) {
                const int row = row0 + ai * HALF + m * 16;
                float sc;
                if (ssqp) { const f32x4* p = (const f32x4*)(ssqp + (size_t)row * 16); const f32x4 s = (p[0] + p[1]) + (p[2] + p[3]); sc = __builtin_amdgcn_rsqf(((s[0] + s[1]) + (s[2] + s[3])) * (1.0f / 1024.0f) + 1e-6f); }
                else sc = rs[row];
                bf16_t* rowp = O + (size_t)row * ldc + col0;
#pragma unroll
                for (int bj = 0; bj < 2; ++bj) {
                    const f32x4 v0 = acc[ai][bj][m][0] * sc, v1 = acc[ai][bj][m][1] * sc;
                    u32x4 w; w.x = pk2bf(v0[0], v0[1]); w.y = pk2bf(v0[2], v0[3]); w.z = pk2bf(v1[0], v1[1]); w.w = pk2bf(v1[2], v1[3]);
                    *(u32x4*)(rowp + bj * HALF) = w;
                }
            }
    }
};
struct EpiResid {
    static constexpr bool PERM = true, AFTER_DRAIN = false;
    const bf16_t* XI; bf16_t* XB; float* ssqp;
    __device__ __forceinline__ void operator()(const f32x4 (&acc)[2][2][4][2], const Unit& u, int wr, int wc, int fr, int fq) const {
        const int row0 = u.pm * BM + wr * 64 + fr, col0 = u.pn * BM + wc * 32 + 8 * fq;
        constexpr int NPF = 5;
        u32x4 xr[NPF + 1][2];
#define ER_LOAD(slot, it) { const bf16_t* pi_ = XI + (size_t)(row0 + ((it) >> 2) * HALF + ((it) & 3) * 16) * 1024 + col0; xr[slot][0] = *(const u32x4*)pi_; xr[slot][1] = *(const u32x4*)(pi_ + HALF); }
#pragma unroll
        for (int it = 0; it < NPF; ++it) ER_LOAD(it, it)
#pragma unroll
        for (int it = 0; it < 8; ++it) {
            if (it + NPF < 8) ER_LOAD((it + NPF) % (NPF + 1), it + NPF)
            const int ai = it >> 2, m = it & 3, row = row0 + ai * HALF + m * 16;
            float ss = 0.f;
#pragma unroll
            for (int bj = 0; bj < 2; ++bj) {
                const u32x4 xv = xr[it % (NPF + 1)][bj];
                const f32x4 xa = {lo_bf(xv.x), hi_bf(xv.x), lo_bf(xv.y), hi_bf(xv.y)}, xc = {lo_bf(xv.z), hi_bf(xv.z), lo_bf(xv.w), hi_bf(xv.w)};
                const f32x4 a = xa + acc[ai][bj][m][0], b = xc + acc[ai][bj][m][1];
                ss += (a[0] * a[0] + a[1] * a[1]) + (a[2] * a[2] + a[3] * a[3]) + (b[0] * b[0] + b[1] * b[1]) + (b[2] * b[2] + b[3] * b[3]);
                u32x4 w; w.x = pk2bf(a[0], a[1]); w.y = pk2bf(a[2], a[3]); w.z = pk2bf(b[0], b[1]); w.w = pk2bf(b[2], b[3]);
                *(u32x4*)(XB + (size_t)row * 1024 + col0 + bj * HALF) = w;
            }
            ss += __shfl_xor(ss, 16); ss += __shfl_xor(ss, 32);
            if (fq == 0) ssqp[(size_t)row * 16 + u.pn * 4 + wc] = ss;
        }
#undef ER_LOAD
    }
};

template <class Epi, class Sched, bool ALIGN_EPI = false, bool SP2 = false>
__device__ __forceinline__ void gemm_phase(PG8_LAS unsigned char* lds, const Gemm g, const Sched& S, const Epi& E, const int tid) {
    const int wid = __builtin_amdgcn_readfirstlane(tid >> 6), lane = tid & 63, wr = wid >> 2, wc = wid & 3, fr = lane & 15, fq = lane >> 4;
    const int K = g.K, nt = K / BK;
    unsigned voffA[2], voffB[2];
#pragma unroll
    for (int i = 0; i < 2; ++i) { int R, C; stage_rc(tid * 16 + i * 8192, R, C); const int Rb = Epi::PERM ? ((R & ~31) + perm32(R & 31)) : R;
        voffA[i] = (unsigned)(R * K + C) * 2u; voffB[i] = (unsigned)(Rb * K + C) * 2u; }
    const size_t kstep = (size_t)(BK * 2);
    const size_t hstep = (size_t)HALF * K * 2;
    const size_t tstep = 2 * hstep;
    const unsigned ldsw = (unsigned)wid * 1024u;
    const int aoff = lds_byte(wr * 64 + fr, fq * 8), boff = lds_byte(wc * 32 + fr, fq * 8);
#define PG8_SA(b, h) (((b) * 2 + (h)) * HTB)
#define PG8_SB(b, h) ((4 + (b) * 2 + (h)) * HTB)
#define PG8_STAGE(bufoff, gbase, voff) do { _Pragma("unroll") for (int _i = 0; _i < 2; ++_i) \
        __builtin_amdgcn_global_load_lds((const unsigned*)((const char*)(gbase) + (voff)[_i]), (PG8_LAS unsigned*)(lds + (bufoff) + ldsw + _i * 8192), 16, 0, 0); } while (0)
#define PG8_LDA(dst, b, h) do { _Pragma("unroll") for (int m = 0; m < 4; ++m) _Pragma("unroll") for (int k = 0; k < 2; ++k) dst[m][k] = *(const PG8_LAS bf16x8*)(lds + PG8_SA(b, h) + aoff + m * 2048 + k * 1024); } while (0)
#define PG8_LDB(dst, b, h) do { _Pragma("unroll") for (int n = 0; n < 2; ++n) _Pragma("unroll") for (int k = 0; k < 2; ++k) dst[n][k] = *(const PG8_LAS bf16x8*)(lds + PG8_SB(b, h) + boff + n * 2048 + k * 1024); } while (0)
#define PG8_MMA(ai, bj, At, Bt) do { __builtin_amdgcn_s_setprio(1); _Pragma("unroll") for (int m = 0; m < 4; ++m) _Pragma("unroll") for (int n = 0; n < 2; ++n) _Pragma("unroll") for (int k = 0; k < 2; ++k) \
        acc[ai][bj][m][n] = __builtin_amdgcn_mfma_f32_16x16x32_bf16(Bt[n][k], At[m][k], acc[ai][bj][m][n], 0, 0, 0); __builtin_amdgcn_s_setprio(0); } while (0)
#define PG8_WAIT_V(n) asm volatile("s_waitcnt vmcnt(" #n ")" ::: "memory")
#define PG8_WAIT_L(n) asm volatile("s_waitcnt lgkmcnt(" #n ")" ::: "memory")
#define PG8_BAR __builtin_amdgcn_s_barrier()
#define PG8_SCHED __builtin_amdgcn_sched_barrier(0)
    Unit cur, nxt; int ui = 0;
    if (!S.next(0, cur)) return;
    f32x4 acc[2][2][4][2];
#pragma unroll
    for (int a = 0; a < 2; ++a)
#pragma unroll
        for (int b = 0; b < 2; ++b)
#pragma unroll
            for (int m = 0; m < 4; ++m)
#pragma unroll
                for (int n = 0; n < 2; ++n) acc[a][b][m][n] = (f32x4){0.f, 0.f, 0.f, 0.f};
    bf16x8 At[4][2], B0[2][2], B1[2][2];
    const char* cA = (const char*)g.A + (size_t)cur.pm * tstep; const char* cB = (const char*)g.Bt + (size_t)cur.pn * tstep;
    S.a_ready(cur);
    if constexpr (SP2) {
        PG8_STAGE(PG8_SB(0, 0), cB, voffB); PG8_STAGE(PG8_SB(0, 1), cB + hstep, voffB); PG8_STAGE(PG8_SA(0, 0), cA, voffA); PG8_STAGE(PG8_SA(0, 1), cA + hstep, voffA);
        if (wr == 1) PG8_BAR;
        PG8_WAIT_V(2); PG8_BAR;
        PG8_STAGE(PG8_SB(1, 0), cB + kstep, voffB); PG8_STAGE(PG8_SA(1, 0), cA + kstep, voffA); PG8_STAGE(PG8_SB(1, 1), cB + hstep + kstep, voffB);
        PG8_WAIT_V(6); PG8_BAR;
    } else {
        PG8_STAGE(PG8_SB(0, 0), cB, voffB); PG8_STAGE(PG8_SA(0, 0), cA, voffA); PG8_STAGE(PG8_SB(0, 1), cB + hstep, voffB); PG8_STAGE(PG8_SA(0, 1), cA + hstep, voffA);
        if (wr == 1) PG8_BAR;
        PG8_WAIT_V(4); PG8_BAR;
        PG8_STAGE(PG8_SB(1, 0), cB + kstep, voffB); PG8_STAGE(PG8_SA(1, 0), cA + kstep, voffA); PG8_STAGE(PG8_SB(1, 1), cB + hstep + kstep, voffB);
        PG8_WAIT_V(6); PG8_BAR;
    }
    for (;;) {
        const bool has_next = S.next(ui + 1, nxt);
        const char* nA = has_next ? (const char*)g.A + (size_t)nxt.pm * tstep : cA; const char* nB = has_next ? (const char*)g.Bt + (size_t)nxt.pn * tstep : cB;
        for (int t = 0; t < nt; t += 2) {
            const bool last = (t == nt - 2);
            const char* a1 = cA + (size_t)(t + 1) * kstep;
            const char* a2 = last ? nA : cA + (size_t)(t + 2) * kstep; const char* b2 = last ? nB : cB + (size_t)(t + 2) * kstep;
            const char* a3 = a2 + kstep; const char* b3 = b2 + kstep;
            if (last && has_next) S.a_ready(nxt);
            if constexpr (SP2) {
            PG8_LDB(B0, 0, 0); PG8_LDB(B1, 0, 1); PG8_SCHED; PG8_LDA(At, 0, 0); PG8_STAGE(PG8_SA(1, 1), a1 + hstep, voffA);
            PG8_WAIT_V(8); PG8_WAIT_L(0); PG8_BAR; PG8_MMA(0, 0, At, B0); PG8_MMA(0, 1, At, B1); PG8_BAR; PG8_SCHED;
            PG8_LDA(At, 0, 1); PG8_STAGE(PG8_SB(0, 0), b2, voffB); PG8_STAGE(PG8_SB(0, 1), b2 + hstep, voffB); PG8_STAGE(PG8_SA(0, 0), a2, voffA);
            PG8_WAIT_V(8); PG8_WAIT_L(0); PG8_BAR; PG8_MMA(1, 0, At, B0); PG8_MMA(1, 1, At, B1); PG8_BAR; PG8_SCHED;
            PG8_LDB(B0, 1, 0); PG8_LDB(B1, 1, 1); PG8_SCHED; PG8_LDA(At, 1, 0); PG8_STAGE(PG8_SA(0, 1), a2 + hstep, voffA);
            PG8_WAIT_V(8); PG8_WAIT_L(0); PG8_BAR; PG8_MMA(0, 0, At, B0); PG8_MMA(0, 1, At, B1); PG8_BAR; PG8_SCHED;
            PG8_LDA(At, 1, 1); PG8_STAGE(PG8_SB(1, 0), b3, voffB); PG8_STAGE(PG8_SB(1, 1), b3 + hstep, voffB); PG8_STAGE(PG8_SA(1, 0), a3, voffA);
            PG8_WAIT_V(8); PG8_WAIT_L(0); PG8_BAR; PG8_MMA(1, 0, At, B0); PG8_MMA(1, 1, At, B1); PG8_BAR; PG8_SCHED;
            } else {
            PG8_LDB(B0, 0, 0); PG8_SCHED; PG8_LDA(At, 0, 0); PG8_STAGE(PG8_SA(1, 1), a1 + hstep, voffA);
            PG8_WAIT_L(8); PG8_BAR; PG8_WAIT_L(0); PG8_MMA(0, 0, At, B0); PG8_BAR; PG8_SCHED;
            PG8_LDB(B1, 0, 1); PG8_STAGE(PG8_SB(0, 0), b2, voffB);
            PG8_BAR; PG8_WAIT_L(0); PG8_MMA(0, 1, At, B1); PG8_BAR;
            PG8_LDA(At, 0, 1); PG8_STAGE(PG8_SA(0, 0), a2, voffA);
            PG8_BAR; PG8_WAIT_L(0); PG8_MMA(1, 0, At, B0); PG8_BAR; PG8_SCHED;
            PG8_STAGE(PG8_SB(0, 1), b2 + hstep, voffB);
            PG8_WAIT_V(6); PG8_BAR; PG8_MMA(1, 1, At, B1); PG8_BAR;
            PG8_LDB(B0, 1, 0); PG8_SCHED; PG8_LDA(At, 1, 0); PG8_STAGE(PG8_SA(0, 1), a2 + hstep, voffA);
            PG8_WAIT_L(8); PG8_BAR; PG8_WAIT_L(0); PG8_MMA(0, 0, At, B0); PG8_BAR; PG8_SCHED;
            PG8_LDB(B1, 1, 1); PG8_STAGE(PG8_SB(1, 0), b3, voffB);
            PG8_BAR; PG8_WAIT_L(0); PG8_MMA(0, 1, At, B1); PG8_BAR;
            PG8_LDA(At, 1, 1); PG8_STAGE(PG8_SA(1, 0), a3, voffA);
            PG8_BAR; PG8_WAIT_L(0); PG8_MMA(1, 0, At, B0); PG8_BAR; PG8_SCHED;
            PG8_STAGE(PG8_SB(1, 1), b3 + hstep, voffB);
            PG8_WAIT_V(6); PG8_BAR; PG8_MMA(1, 1, At, B1); PG8_BAR;
            }
        }
        if constexpr (ALIGN_EPI) { if (wr == 0) PG8_BAR; }
        if constexpr (!Epi::AFTER_DRAIN) { E(acc, cur, wr, wc, fr, fq); S.done(cur); }
        if (!has_next) break;
#pragma unroll
        for (int a = 0; a < 2; ++a)
#pragma unroll
            for (int b = 0; b < 2; ++b)
#pragma unroll
                for (int m = 0; m < 4; ++m)
#pragma unroll
                    for (int n = 0; n < 2; ++n) acc[a][b][m][n] = (f32x4){0.f, 0.f, 0.f, 0.f};
        cur = nxt; cA = nA; cB = nB; ++ui;
        if constexpr (ALIGN_EPI) { if (wr == 1) PG8_BAR; }
    }
    PG8_WAIT_V(0);
    if constexpr (!ALIGN_EPI) { if (wr == 0) PG8_BAR; }
    PG8_BAR;
    if constexpr (Epi::AFTER_DRAIN) { E.fused(acc, cur, wr, wc, fr, fq, lds, wid, lane); S.done(cur); }
#undef PG8_SA
#undef PG8_SB
#undef PG8_STAGE
#undef PG8_LDA
#undef PG8_LDB
#undef PG8_MMA
#undef PG8_WAIT_V
#undef PG8_WAIT_L
#undef PG8_BAR
#undef PG8_SCHED
}
}

#define XB_TMO      128
#define XB_XCNT(j)  (256  + 64 * (j))
#define XB_XSUB(j)  (1280 + 64 * (j))
#define XB_XGEN(j)  (2304 + 64 * (j))
#define XB_TOP      3328
#define XB_TOPGEN   3392
#define XCD_BAR_WORDS 3456
#define XB_SPIN_CAP (1u << 22)

__device__ __forceinline__ unsigned xb_ld(unsigned* p)              { return __hip_atomic_load(p, __ATOMIC_RELAXED, __HIP_MEMORY_SCOPE_AGENT); }
__device__ __forceinline__ unsigned xb_add(unsigned* p, unsigned v) { return __hip_atomic_fetch_add(p, v, __ATOMIC_RELAXED, __HIP_MEMORY_SCOPE_AGENT); }
__device__ __forceinline__ unsigned xb_xcc_id() { return (unsigned)__builtin_amdgcn_s_getreg((3 << 11) | 20) & 0xFu; }
#define XB_SPIN(cond, bar) do { unsigned _sp = 0; while (cond) { __builtin_amdgcn_s_sleep(1); \
    if ((++_sp & 255u) == 0u) { if (xb_ld(&(bar)[XB_TMO])) break; if (_sp > XB_SPIN_CAP) { atomicAdd(&(bar)[XB_TMO], 1u); break; } } } } while (0)

struct XcdBarrier {
    unsigned* bar; unsigned x;
    volatile LAS unsigned* st;
};

__device__ __forceinline__ XcdBarrier xcd_barrier_post(unsigned* bar, volatile LAS unsigned* st) {
    XcdBarrier b; b.bar = bar; b.x = xb_xcc_id(); b.st = st;
    if (threadIdx.x == 0) (void)xb_add(&bar[XB_XCNT(b.x)], 1u);
    return b;
}
__device__ __forceinline__ void xcd_barrier_complete(unsigned* bar, unsigned x, unsigned& nloc, unsigned& nx) {
    const unsigned G = gridDim.x * gridDim.y * gridDim.z;
    unsigned sum, cnt, mine, sp = 0u;
    for (;;) {
        sum = 0u; cnt = 0u; mine = 0u;
#pragma unroll
        for (unsigned j = 0; j < 16; ++j) { const unsigned c = xb_ld(&bar[XB_XCNT(j)]); sum += c; cnt += (c > 0u) ? 1u : 0u; mine = (j == x) ? c : mine; }
        if (sum == G) break;
        __builtin_amdgcn_s_sleep(1);
        if ((++sp & 255u) == 0u) { if (xb_ld(&bar[XB_TMO])) break; if (sp > XB_SPIN_CAP) { atomicAdd(&bar[XB_TMO], 1u); break; } }
    }
    nloc = mine > 0u ? mine : 1u; nx = cnt > 0u ? cnt : 1u;
}

__device__ __forceinline__ void xcd_barrier(const XcdBarrier& b) {
    asm volatile("s_waitcnt vmcnt(0)" ::: "memory");
    __syncthreads();
    if (threadIdx.x == 0) {
        unsigned* bar = b.bar;
        __builtin_amdgcn_s_waitcnt(0);
        unsigned nloc = b.st[0], nx = b.st[1];
        if (nloc == 0u) { xcd_barrier_complete(bar, b.x, nloc, nx); b.st[0] = nloc; b.st[1] = nx; }
        const unsigned old = xb_add(&bar[XB_XSUB(b.x)], 1u);
        const unsigned gen = old / nloc;
        if (old + 1u == (gen + 1u) * nloc) {
            __builtin_amdgcn_fence(__ATOMIC_RELEASE, "agent");
            asm volatile("s_waitcnt vmcnt(0)" ::: "memory");
            const unsigned og = xb_add(&bar[XB_TOP], 1u);
            const unsigned tg = og / nx;
            if (og + 1u == (tg + 1u) * nx) xb_add(&bar[XB_TOPGEN], 1u);
            else XB_SPIN(xb_ld(&bar[XB_TOPGEN]) == tg, bar);
            __builtin_amdgcn_fence(__ATOMIC_ACQUIRE, "agent");
            xb_add(&bar[XB_XGEN(b.x)], 1u);
            asm volatile("s_waitcnt vmcnt(0)" ::: "memory");
        } else {
            XB_SPIN(xb_ld(&bar[XB_XGEN(b.x)]) == gen, bar);
            __builtin_amdgcn_fence(__ATOMIC_ACQUIRE, "agent");
            asm volatile("s_waitcnt vmcnt(0)" ::: "memory");
        }
    }
    __syncthreads();
}

#ifndef PROBE_K
#define PROBE_K (-1)
#endif
#ifndef PROBE_REP
#define PROBE_REP 3
#endif
namespace cg = cooperative_groups;
constexpr int NTHR = 512, NWAVE = 8;
constexpr int PH_PER_LAYER = 7;
constexpr int N_PRE = 1;
constexpr int N_PHASES = N_PRE + NL * PH_PER_LAYER;
constexpr int LDS_BYTES = 144 * 1024;

struct Args { const float* in[26]; float* out; unsigned char* ws; int ph_lo, ph_hi; };

__global__ void __launch_bounds__(NTHR, 2) mega(Args a) {
    extern __shared__ __attribute__((aligned(16))) unsigned char lds[];
    cg::grid_group grid = cg::this_grid();
    const int G = gridDim.x;
    XcdBarrier xbar;
    { volatile LAS unsigned* stw = (volatile LAS unsigned*)((LAS unsigned char*)lds + LDS_BYTES - 32);
      if (threadIdx.x < 4) stw[threadIdx.x] = 0u;
      __syncthreads();
      WS w0; ws_carve(a.ws, w0);
      xbar = xcd_barrier_post(w0.bar, stw); }
    const float* x = a.in[0]; const float* norm1_g = a.in[1]; const float* w_in = a.in[2];
    const float* lam_re = a.in[3]; const float* lam_im = a.in[4]; const float* log_step = a.in[5];
    const float* b_re = a.in[6]; const float* b_im = a.in[7]; const float* c_re = a.in[8]; const float* c_im = a.in[9];
    const float* ssm_d = a.in[10]; const float* w_glu = a.in[11]; const float* ssm_g = a.in[12]; const float* dil_g = a.in[13];
    const float* lq1 = a.in[14]; const float* lk1 = a.in[15]; const float* lq2 = a.in[16]; const float* lk2 = a.in[17];
    const float* subg = a.in[18]; const float* w_out = a.in[19]; const float* norm2_g = a.in[20];
    const float* w_query = a.in[21]; const float* sub_keys = a.in[22]; const float* peer_u = a.in[23]; const float* peer_v = a.in[24];
    const float* fin_g = a.in[25];

    for (int ph = a.ph_lo; ph < a.ph_hi; ++ph) {
        int reps = 1;
#if PROBE_K >= 0
        if (PROBE_K >= 100 ? (ph == PROBE_K - 100) : (ph >= N_PRE && (ph - N_PRE) % PH_PER_LAYER == (PROBE_K == 50 ? 0 : PROBE_K))) reps = PROBE_REP;
#endif
      for (int rep_i = 0; rep_i < reps; ++rep_i) {
        int tid = threadIdx.x, bid = blockIdx.x; size_t zoff = 0;
        asm volatile("" : "+v"(tid)); asm volatile("" : "+s"(bid)); asm volatile("" : "+s"(zoff));
        unsigned char* wsb = a.ws + zoff;
        WS w; ws_carve(wsb, w);
        S5Tab st; st.Ktab = w.s5k; st.Wend = w.s5we; st.Wout = w.s5wo; st.lam_re = lam_re; st.lam_im = lam_im; st.log_step = log_step;
        const int lane = tid & 63, wv = __builtin_amdgcn_readfirstlane(tid >> 6);
        const int gw = bid * NWAVE + wv, nw = G * NWAVE;
        const size_t gtid = (size_t)bid * NTHR + tid, gthreads = (size_t)G * NTHR;
        if (PROBE_K == 50 && rep_i > 0) {
        } else if (ph == 0) {
            float* tile = (float*)lds;
            constexpr int T_IN = (INW / 64) * (DM / 64), T_OUT = (DM / 64) * (DM / 64), T_Q = (2048 / 64) * (DM / 64), T_G = (SSMW / 64) * (SSMW / 64);
            constexpr int T_L = T_IN + T_OUT + T_Q + T_G;
            for (int it = bid; it < NL * NG * 8; it += G) s5_prep_task((LAS unsigned char*)lds, st, lam_re, lam_im, log_step, b_re, b_im, c_re, c_im, ssm_d, it >> 3, it & 7, tid);
            for (int it = bid; it < NL * T_L; it += G) {
                const int l = it / T_L; int r = it % T_L;
                if (r < T_IN) transpose_tile(tile, w_in + (size_t)l * DM * INW, norm1_g + l * DM, w.WinT + (size_t)l * INW * DM, DM, INW, (r % (INW / 64)) * 64, (r / (INW / 64)) * 64, tid);
                else if ((r -= T_IN) < T_OUT) transpose_tile(tile, w_out + (size_t)l * DM * DM, nullptr, w.WoutT + (size_t)l * DM * DM, DM, DM, (r % (DM / 64)) * 64, (r / (DM / 64)) * 64, tid);
                else if ((r -= T_OUT) < T_Q) transpose_tile(tile, w_query + (size_t)l * DM * 2048, norm2_g + l * DM, w.WqT + (size_t)l * 2048 * DM, DM, 2048, (r % (2048 / 64)) * 64, (r / (2048 / 64)) * 64, tid);
                else { r -= T_Q; transpose_tile(tile, w_glu + (size_t)l * SSMW * SSMW, nullptr, w.WgluT + (size_t)l * SSMW * SSMW, SSMW, SSMW, (r % (SSMW / 64)) * 64, (r / (SSMW / 64)) * 64, tid); }
            }
            convert_body(sub_keys, nullptr, w.SKb, (size_t)NL * PH * 2 * PK * PHALF / 8, PHALF, 1, gtid, gthreads);
            convert_fp6_body(peer_u, norm2_g, w.U8, NL * PE / 2, PEER_USCALE, gw, nw, lane);
            convert_fp6_body(peer_v, nullptr, w.V8, NL * PE / 2, PEER_VSCALE, gw, nw, lane);
            for (int row = gw; row < T; row += nw) rowstat_body(x, nullptr, w.xb, w.rs1, row, lane);
        } else {
            const int l = (ph - N_PRE) / PH_PER_LAYER, k = (ph - N_PRE) % PH_PER_LAYER;
            if (k == 0) {
                pg8::Gemm g{w.xb, w.WinT + (size_t)l * INW * DM, T, INW, DM}; pg8::SkipOrder S; S.so.init(T, INW - 256, G, bid); S.skip = A_DEFER;
                pg8::EpiScaleBf16 E{w.proj, INW, w.rs1, nullptr};
                pg8::gemm_phase<pg8::EpiScaleBf16, pg8::SkipOrder, true, true>((LAS unsigned char*)lds, g, S, E, tid);
            } else if (k == 1) {
                AttnOut ao; ao.cat = w.cat; ao.dilO = w.dilO; ao.dilL = w.dilL; ao.subg = subg; ao.layer = l;
                { float s1 = 0.f, s2 = 0.f; for (int i = 0; i < 32; ++i) { s1 += lq1[l * 32 + i] * lk1[l * 32 + i]; s2 += lq2[l * 32 + i] * lk2[l * 32 + i]; }
                  ao.lam_init = 0.8f - 0.6f * expf(-0.3f * (float)l); ao.lam = expf(s1) - expf(s2) + ao.lam_init; }
                volatile LAS unsigned* uq = (volatile LAS unsigned*)(lds + LDS_BYTES - 16);
                bool dil_ready = false;
                for (;;) {
                    if (tid == 0) uq[0] = atomicAdd(&w.ctr[l * 8 + rep_i], 1u);
                    __syncthreads();
                    const unsigned u = uq[0];
                    __syncthreads();
                    if (u >= (unsigned)(N_ATTN_UNITS + NB * NG + T / 256)) break;
                    int tu = tid; asm volatile("" : "+v"(tu));
                    if (u < (unsigned)(T / 256)) {
                        pg8::Gemm g{w.xb, w.WinT + (size_t)l * INW * DM, T, INW, DM}; pg8::OneUnit S1{(int)u, A_DEFER};
                        pg8::EpiScaleBf16 E{w.proj, INW, w.rs1, nullptr};
                        pg8::gemm_phase<pg8::EpiScaleBf16, pg8::OneUnit, false, true>((LAS unsigned char*)lds, g, S1, E, tu);
                        asm volatile("s_waitcnt vmcnt(0)" ::: "memory");
                        __syncthreads();
                        if (tid == 0) { __builtin_amdgcn_fence(__ATOMIC_RELEASE, "agent"); asm volatile("s_waitcnt vmcnt(0)" ::: "memory");
                                        __hip_atomic_fetch_add(&w.ctr[256 + l * 4 + rep_i], 1u, __ATOMIC_RELAXED, __HIP_MEMORY_SCOPE_AGENT); }
                    } else {
                        const unsigned v = u - (unsigned)(T / 256);
                        if (v >= 256u + NB * NG && !dil_ready) {
                            if (tid == 0) { unsigned sp = 0; while (__hip_atomic_load(&w.ctr[256 + l * 4 + rep_i], __ATOMIC_RELAXED, __HIP_MEMORY_SCOPE_AGENT) < (unsigned)(T / 256)) { __builtin_amdgcn_s_sleep(4); if (++sp > (1u << 26)) break; }
                                            __builtin_amdgcn_fence(__ATOMIC_ACQUIRE, "agent"); asm volatile("s_waitcnt vmcnt(0)" ::: "memory"); }
                            __syncthreads();
                            dil_ready = true;
                        }
                        if (v >= 256u && v < 256u + NB * NG) s5_unit((LAS unsigned char*)lds, w, st, l, (int)(v - 256u) / NG, (int)(v - 256u) % NG, tu);
                        else attn_dispatch((LAS unsigned char*)lds, w, (v < 256u) ? (int)v : (int)v - NB * NG, ao, tu);
                    }
                }
            } else if (k == 2) {
                for (int u = bid; u < T / 64; u += G) b2_fast_unit((LAS unsigned char*)lds, w, l, ssm_g, dil_g, 64 * u, tid);
            } else if (k == 3) {
                pg8::Gemm g{w.cat, w.WoutT + (size_t)l * DM * DM, T, DM, DM}; pg8::StaticOrder S; S.init(T, DM, G, bid);
                pg8::EpiResid E{w.xb, w.xb1, w.ssqp};
                pg8::gemm_phase<pg8::EpiResid, pg8::StaticOrder, true, true>((LAS unsigned char*)lds, g, S, E, tid);
            } else if (k == 4) {
                pg8::Gemm g{w.xb1, w.WqT + (size_t)l * 2048 * DM, T, 2048, DM}; pg8::StaticOrder S; S.init(T, 2048, G, bid);
                pg8::EpiScaleBf16 E{w.q, 2048, nullptr, w.ssqp};
                pg8::gemm_phase<pg8::EpiScaleBf16, pg8::StaticOrder, true, true>((LAS unsigned char*)lds, g, S, E, tid);
#if PROBE_K != 5
                { const bf16_t* skg = w.SKb + ((size_t)l * PH + (bid & 7)) * 2 * PK * PHALF;
                  for (int i = tid; i < 256 * 16; i += NTHR) { const int row = i >> 4, pc = i & 15; *(LAS u32x4*)((LAS unsigned char*)lds + row * RT_SKP + pc * 16) = *(const u32x4*)(skg + (size_t)row * PHALF + pc * 8); } }
#endif
            } else if (k == 5) {
                const int h = bid & 7, nbh = G >> 3;
#if PROBE_K == 5
                { const bf16_t* skg = w.SKb + ((size_t)l * PH + h) * 2 * PK * PHALF;
                  for (int i = tid; i < 256 * 16; i += NTHR) { const int row = i >> 4, pc = i & 15; *(LAS u32x4*)((LAS unsigned char*)lds + row * RT_SKP + pc * 16) = *(const u32x4*)(skg + (size_t)row * PHALF + pc * 8); } }
#endif
                __syncthreads();
                volatile __attribute__((address_space(3))) unsigned* ldsw = (volatile __attribute__((address_space(3))) unsigned*)((LAS unsigned char*)lds + RT_SK_BYTES) + wv * (64 * 9);
                if ((G & 7) == 0) { for (int tb = (bid >> 3) + nbh * wv; tb < T / 32; tb += nbh * NWAVE) route_fast_unit(w, (const LAS unsigned char*)lds, tb, h, lane, ldsw); }
                __syncthreads();
            } else {
                peer_fast_wave(w, l, fin_g, (l == NL - 1) ? a.out : nullptr, gw, nw, lane);
            }
        }
        if (rep_i + 1 < reps) xcd_barrier(xbar);
      }
        if (ph + 1 < a.ph_hi) { if (a.ph_lo < 0) grid.sync(); else xcd_barrier(xbar); }
    }
}

#ifndef MK_ONE_LAUNCH
#define MK_ONE_LAUNCH 1
#endif
extern "C" void kernel_launch(void* const* d_in, const int* in_sizes, int n_in, void* d_out, int out_size, void* d_ws, size_t ws_size, hipStream_t stream) {
    static int grid = 0;
    if (grid == 0) {
        WS w; const size_t need = ws_carve((unsigned char*)d_ws, w);
        if (n_in != 26 || out_size != T * DM || ws_size < need) { fprintf(stderr, "kernel_launch: unexpected shapes (n_in %d out %d ws %zu need %zu)\n", n_in, out_size, ws_size, need); grid = -1; return; }
        int dev = 0, cus = 0, per_cu = 0;
        (void)hipGetDevice(&dev);
        (void)hipDeviceGetAttribute(&cus, hipDeviceAttributeMultiprocessorCount, dev);
        (void)hipFuncSetAttribute((const void*)mega, hipFuncAttributeMaxDynamicSharedMemorySize, LDS_BYTES);
        (void)hipOccupancyMaxActiveBlocksPerMultiprocessor(&per_cu, (const void*)mega, NTHR, LDS_BYTES);
        if (per_cu < 1) { fprintf(stderr, "kernel_launch: occupancy query says %d blocks/CU\n", per_cu); grid = -1; return; }
        grid = cus;
        fprintf(stderr, "kernel_launch: cus %d per_cu %d grid %d\n", cus, per_cu, grid);
    }
    if (grid < 0) return;
    { WS w; ws_carve((unsigned char*)d_ws, w);
      if (hipMemsetAsync(w.ctr, 0, 4096 + XCD_BAR_WORDS_C * 4, stream) != hipSuccess) { fprintf(stderr, "kernel_launch: memset of control words failed\n"); return; } }
    Args a{};
    for (int i = 0; i < 26; ++i) a.in[i] = (const float*)d_in[i];
    a.out = (float*)d_out; a.ws = (unsigned char*)d_ws;
#if MK_ONE_LAUNCH
    a.ph_lo = 0; a.ph_hi = N_PHASES;
    void* args[] = {&a};
    hipError_t e = hipLaunchCooperativeKernel((const void*)mega, dim3(grid), dim3(NTHR), args, LDS_BYTES, stream);
    if (e != hipSuccess) fprintf(stderr, "cooperative launch failed: %s (grid %d)\n", hipGetErrorString(e), grid);
#else
    for (int ph = 0; ph < N_PHASES; ++ph) { a.ph_lo = ph; a.ph_hi = ph + 1; hipLaunchKernelGGL(mega, dim3(grid), dim3(NTHR), LDS_BYTES, stream, a); }
#endif
}
```

```cpp
#include <hip/hip_runtime.h>
#include <hip/hip_cooperative_groups.h>
#include <cstdint>
#include <cstdio>
#include <cmath>

typedef unsigned short bf16_t;
typedef short bf16x8 __attribute__((ext_vector_type(8)));
typedef float f32x4 __attribute__((ext_vector_type(4)));
typedef unsigned u32x4 __attribute__((ext_vector_type(4)));
typedef unsigned u32x2 __attribute__((ext_vector_type(2)));
typedef float f32x2 __attribute__((ext_vector_type(2)));
#define LAS __attribute__((address_space(3)))

constexpr int T = 16384, DM = 1024, NL = 4, SEQ = 2048, NB = 8;
constexpr int INW = 2304;
constexpr int SSMW = 384, DILW = 384, DIFW = 256;
constexpr int NG = 24, GC = 16, NS = 64;
constexpr int DILH = 6, DIFH = 4;
constexpr int PH = 8, PK = 128, PE = 16384, PTOP = 16, PQD = 256, PHALF = 128;
constexpr int OFF_DQ = 384, OFF_DK = 768, OFF_DV = 1152, OFF_FQ = 1536, OFF_FK = 1792, OFF_FV = 2048;
constexpr float EPS = 1e-6f;
constexpr float PEER_USCALE = 64.0f, PEER_VSCALE = 4.0f;
constexpr int XCD_BAR_WORDS_C = 3456;

__device__ __forceinline__ float bf2f(bf16_t h) { return __uint_as_float(((unsigned)h) << 16); }
__device__ __forceinline__ unsigned pk2(float a, float b) {
    typedef __bf16 bf2 __attribute__((ext_vector_type(2)));
    typedef float f2 __attribute__((ext_vector_type(2)));
    f2 v = {a, b};
    bf2 r = __builtin_convertvector(v, bf2);
    return __builtin_bit_cast(unsigned, r);
}
__device__ __forceinline__ bf16_t f2bf(float a) { return (bf16_t)(pk2(a, 0.f) & 0xffffu); }
__device__ __forceinline__ float lo_bf(unsigned w) { return __uint_as_float(w << 16); }
__device__ __forceinline__ float hi_bf(unsigned w) { return __uint_as_float(w & 0xffff0000u); }
template <int CTRL> __device__ __forceinline__ float dppmov(float v) { return __uint_as_float(__builtin_amdgcn_update_dpp(0u, __float_as_uint(v), CTRL, 0xf, 0xf, true)); }
constexpr int DPP_XOR1 = 0xB1, DPP_XOR2 = 0x4E, DPP_ROR4 = 0x124, DPP_ROR8 = 0x128;
__device__ __forceinline__ float swap16sum(float v) { const auto r = __builtin_amdgcn_permlane16_swap(__float_as_uint(v), __float_as_uint(v), false, false); return __uint_as_float(r[0]) + __uint_as_float(r[1]); }
__device__ __forceinline__ float swap32sum(float v) { const auto r = __builtin_amdgcn_permlane32_swap(__float_as_uint(v), __float_as_uint(v), false, false); return __uint_as_float(r[0]) + __uint_as_float(r[1]); }
__device__ __forceinline__ float wave_sum(float v) {
    v += dppmov<DPP_XOR1>(v); v += dppmov<DPP_XOR2>(v); v += dppmov<DPP_ROR4>(v); v += dppmov<DPP_ROR8>(v);
    return swap32sum(swap16sum(v));
}

struct WS {
    bf16_t *WinT, *WoutT, *WqT, *WgluT, *SKb; unsigned char *U8, *V8;
    bf16_t *xb, *xb1; float *rs1, *rs2, *ssqp;
    bf16_t *proj, *yssm, *ydil, *cat, *q, *dilO; float* dilL; unsigned* ctr;
    bf16_t *s5k, *s5we, *s5wo; unsigned* bar;
    int* pidx; float* pgate;
};
__host__ __device__ inline size_t ws_carve(unsigned char* base, WS& w) {
    size_t o = 0;
#define TAKE(ptr, type, bytes) do { ptr = (type)(base + o); o += (((size_t)(bytes)) + 255) & ~(size_t)255; } while (0)
    TAKE(w.WinT, bf16_t*, (size_t)NL * INW * DM * 2);
    TAKE(w.WoutT, bf16_t*, (size_t)NL * DM * DM * 2);
    TAKE(w.WqT, bf16_t*, (size_t)NL * 2048 * DM * 2);
    TAKE(w.WgluT, bf16_t*, (size_t)NL * SSMW * SSMW * 2);
    TAKE(w.SKb, bf16_t*, (size_t)NL * PH * 2 * PK * PHALF * 2);
    TAKE(w.U8, unsigned char*, (size_t)NL * PE * 768);
    TAKE(w.V8, unsigned char*, (size_t)NL * PE * 768);
    TAKE(w.xb, bf16_t*, (size_t)T * DM * 2);
    TAKE(w.xb1, bf16_t*, (size_t)T * DM * 2);
    TAKE(w.rs1, float*, (size_t)T * 4);
    TAKE(w.rs2, float*, (size_t)T * 4);
    TAKE(w.ssqp, float*, (size_t)T * 16 * 4);
    TAKE(w.proj, bf16_t*, (size_t)T * INW * 2);
    TAKE(w.yssm, bf16_t*, (size_t)T * SSMW * 2);
    TAKE(w.ydil, bf16_t*, (size_t)T * DILW * 2);
    TAKE(w.dilO, bf16_t*, (size_t)3 * T * DILW * 2);
    TAKE(w.dilL, float*, (size_t)3 * T * DILH * 4);
    TAKE(w.ctr, unsigned*, 4096);
    TAKE(w.bar, unsigned*, XCD_BAR_WORDS_C * 4);
    TAKE(w.s5k, bf16_t*, (size_t)NL * NG * 64 * 256 * 2);
    TAKE(w.s5we, bf16_t*, (size_t)NL * NG * 64 * 128 * 16 * 2);
    TAKE(w.s5wo, bf16_t*, (size_t)NL * NG * 64 * 128 * 16 * 2);
    TAKE(w.cat, bf16_t*, (size_t)T * DM * 2);
    TAKE(w.q, bf16_t*, (size_t)T * 2048 * 2);
    TAKE(w.pidx, int*, (size_t)T * 128 * 4);
    TAKE(w.pgate, float*, (size_t)T * 128 * 4);
#undef TAKE
    return o;
}

__device__ __forceinline__ void transpose_tile(float* tile, const float* __restrict__ in, const float* __restrict__ gain, bf16_t* __restrict__ out, int K, int N, int n0, int k0, int tid) {
#pragma unroll
    for (int i = 0; i < 2; ++i) {
        const int q = tid + 512 * i, kk = q >> 4, n4 = (q & 15) * 4;
        f32x4 v = *(const f32x4*)(in + (size_t)(k0 + kk) * N + n0 + n4);
        if (gain) v = v * gain[k0 + kk];
        tile[kk * 65 + n4] = v[0]; tile[kk * 65 + n4 + 1] = v[1]; tile[kk * 65 + n4 + 2] = v[2]; tile[kk * 65 + n4 + 3] = v[3];
    }
    __syncthreads();
    { const int n = tid >> 3, k8 = (tid & 7) * 8;
      u32x4 w; w.x = pk2(tile[(k8 + 0) * 65 + n], tile[(k8 + 1) * 65 + n]); w.y = pk2(tile[(k8 + 2) * 65 + n], tile[(k8 + 3) * 65 + n]);
      w.z = pk2(tile[(k8 + 4) * 65 + n], tile[(k8 + 5) * 65 + n]); w.w = pk2(tile[(k8 + 6) * 65 + n], tile[(k8 + 7) * 65 + n]);
      *(u32x4*)(out + (size_t)(n0 + n) * K + k0 + k8) = w; }
    __syncthreads();
}
struct TTile { const float* in; const float* gain; bf16_t* out; int K, N, n0, k0; };
__device__ __forceinline__ void transpose_tiles(float* tile, int it0, int step, int total, int tid, const float* w_in, const float* norm1_g, const float* w_out, const float* w_query, const float* norm2_g, const float* w_glu, const WS& w) {
    constexpr int T_IN = (INW / 64) * (DM / 64), T_OUT = (DM / 64) * (DM / 64), T_Q = (2048 / 64) * (DM / 64), T_L = T_IN + T_OUT + T_Q;
    auto desc = [&](int it) -> TTile {
        const int l = it / T_L; int r = it % T_L; TTile d;
        if (r < T_IN) d = TTile{w_in + (size_t)l * DM * INW, norm1_g + l * DM, w.WinT + (size_t)l * INW * DM, DM, INW, (r % (INW / 64)) * 64, (r / (INW / 64)) * 64};
        else if ((r -= T_IN) < T_OUT) d = TTile{w_out + (size_t)l * DM * DM, nullptr, w.WoutT + (size_t)l * DM * DM, DM, DM, (r % (DM / 64)) * 64, (r / (DM / 64)) * 64};
        else { r -= T_OUT; d = TTile{w_query + (size_t)l * DM * 2048, norm2_g + l * DM, w.WqT + (size_t)l * 2048 * DM, DM, 2048, (r % (2048 / 64)) * 64, (r / (2048 / 64)) * 64}; }
        return d;
    };
    if (it0 >= total) return;
    const int kk0 = tid >> 4, kk1 = (tid + 512) >> 4, n4 = (tid & 15) * 4;
    TTile c = desc(it0);
    f32x4 v0 = *(const f32x4*)(c.in + (size_t)(c.k0 + kk0) * c.N + c.n0 + n4), v1 = *(const f32x4*)(c.in + (size_t)(c.k0 + kk1) * c.N + c.n0 + n4);
    float g0 = c.gain ? c.gain[c.k0 + kk0] : 1.0f, g1 = c.gain ? c.gain[c.k0 + kk1] : 1.0f;
    for (int it = it0; it < total; it += step) {
        const bool has_next = it + step < total;
        TTile nx = c; f32x4 nv0 = v0, nv1 = v1; float ng0 = g0, ng1 = g1;
        if (has_next) {
            nx = desc(it + step);
            nv0 = *(const f32x4*)(nx.in + (size_t)(nx.k0 + kk0) * nx.N + nx.n0 + n4); nv1 = *(const f32x4*)(nx.in + (size_t)(nx.k0 + kk1) * nx.N + nx.n0 + n4);
            ng0 = nx.gain ? nx.gain[nx.k0 + kk0] : 1.0f; ng1 = nx.gain ? nx.gain[nx.k0 + kk1] : 1.0f;
        }
        { const f32x4 a = v0 * g0, b = v1 * g1;
          tile[kk0 * 65 + n4] = a[0]; tile[kk0 * 65 + n4 + 1] = a[1]; tile[kk0 * 65 + n4 + 2] = a[2]; tile[kk0 * 65 + n4 + 3] = a[3];
          tile[kk1 * 65 + n4] = b[0]; tile[kk1 * 65 + n4 + 1] = b[1]; tile[kk1 * 65 + n4 + 2] = b[2]; tile[kk1 * 65 + n4 + 3] = b[3]; }
        __syncthreads();
        { const int n = tid >> 3, k8 = (tid & 7) * 8;
          u32x4 wq; wq.x = pk2(tile[(k8 + 0) * 65 + n], tile[(k8 + 1) * 65 + n]); wq.y = pk2(tile[(k8 + 2) * 65 + n], tile[(k8 + 3) * 65 + n]);
          wq.z = pk2(tile[(k8 + 4) * 65 + n], tile[(k8 + 5) * 65 + n]); wq.w = pk2(tile[(k8 + 6) * 65 + n], tile[(k8 + 7) * 65 + n]);
          *(u32x4*)(c.out + (size_t)(c.n0 + n) * c.K + c.k0 + k8) = wq; }
        __syncthreads();
        c = nx; v0 = nv0; v1 = nv1; g0 = ng0; g1 = ng1;
    }
}
__device__ __forceinline__ void convert_body(const float* __restrict__ in, const float* __restrict__ gain, bf16_t* __restrict__ out, size_t n8, int cols, size_t elems_per_layer, size_t gtid, size_t gstride) {
    size_t i = gtid;
    const size_t stride = gstride;
    for (; i < n8; i += stride) {
        const size_t e = i * 8;
        const f32x4 a = *(const f32x4*)(in + e), b = *(const f32x4*)(in + e + 4);
        f32x4 ga = {1.f, 1.f, 1.f, 1.f}, gb = ga;
        if (gain) { const size_t l = e / elems_per_layer; const int c = (int)(e % (size_t)cols); ga = *(const f32x4*)(gain + l * cols + c); gb = *(const f32x4*)(gain + l * cols + c + 4); }
        u32x4 w; w.x = pk2(a[0] * ga[0], a[1] * ga[1]); w.y = pk2(a[2] * ga[2], a[3] * ga[3]); w.z = pk2(b[0] * gb[0], b[1] * gb[1]); w.w = pk2(b[2] * gb[2], b[3] * gb[3]);
        *(u32x4*)(out + e) = w;
    }
}

typedef float f32x16v __attribute__((ext_vector_type(16)));
typedef unsigned u32x6 __attribute__((ext_vector_type(6)));
typedef unsigned u32x3 __attribute__((ext_vector_type(3)));
typedef float f32x32 __attribute__((ext_vector_type(32)));
__device__ __forceinline__ void convert_fp6_body(const float* __restrict__ in, const float* __restrict__ gain, unsigned char* __restrict__ data, int first, int npairs, float scale, int gw0, int nw, int lane) {
    const int gw = first + gw0;
    if (gw >= npairs) return;
    f32x4 cur[8], nxt[8];
    { const float* src = in + (size_t)gw * 2048 + 4 * lane;
#pragma unroll
      for (int k = 0; k < 8; ++k) cur[k] = *(const f32x4*)(src + 256 * k); }
    for (int pr = gw; pr < npairs; pr += nw) {
        const int pn = pr + nw;
        if (pn < npairs) { const float* src = in + (size_t)pn * 2048 + 4 * lane;
#pragma unroll
            for (int k = 0; k < 8; ++k) nxt[k] = *(const f32x4*)(src + 256 * k); }
        f32x4 gv[4] = {{scale, scale, scale, scale}, {scale, scale, scale, scale}, {scale, scale, scale, scale}, {scale, scale, scale, scale}};
        if (gain) { const int l = pr / (PE / 2);
#pragma unroll
            for (int k = 0; k < 4; ++k) gv[k] = *(const f32x4*)(gain + l * DM + 256 * k + 4 * lane) * scale; }
        f32x16v ev, od;
#pragma unroll
        for (int k = 0; k < 8; ++k) {
            const f32x4 v = cur[k] * gv[k & 3];
            ev[2 * k] = v[0]; od[2 * k] = v[1]; ev[2 * k + 1] = v[2]; od[2 * k + 1] = v[3];
        }
        const u32x6 p = __builtin_amdgcn_cvt_scalef32_2xpk16_fp6_f32(ev, od, 1.0f);
        const u32x3 r0 = {p[0], p[1], p[2]}, r1 = {p[3], p[4], p[5]};
        *(u32x3*)(data + (size_t)pr * 1536 + 12 * lane) = r0; *(u32x3*)(data + (size_t)pr * 1536 + 768 + 12 * lane) = r1;
#pragma unroll
        for (int k = 0; k < 8; ++k) cur[k] = nxt[k];
    }
}
__device__ __forceinline__ void rowstat_rows(const float* __restrict__ x, bf16_t* __restrict__ xb, float* __restrict__ rs, int row0, int step, int lane) {
    if (row0 >= T) return;
    f32x4 cur[4], nxt[4];
#pragma unroll
    for (int i = 0; i < 4; ++i) cur[i] = *(const f32x4*)(x + (size_t)row0 * DM + (lane + 64 * i) * 4);
    for (int row = row0; row < T; row += step) {
        if (row + step < T) {
#pragma unroll
            for (int i = 0; i < 4; ++i) nxt[i] = *(const f32x4*)(x + (size_t)(row + step) * DM + (lane + 64 * i) * 4);
        }
        float ss = 0.f;
#pragma unroll
        for (int i = 0; i < 4; ++i) {
            const f32x4 v = cur[i];
            ss += v[0] * v[0] + v[1] * v[1] + v[2] * v[2] + v[3] * v[3];
            u32x2 w; w.x = pk2(v[0], v[1]); w.y = pk2(v[2], v[3]);
            *(u32x2*)(xb + (size_t)row * DM + (lane + 64 * i) * 4) = w;
        }
        ss = wave_sum(ss);
        if (lane == 0) rs[row] = rsqrtf(ss * (1.0f / DM) + EPS);
#pragma unroll
        for (int i = 0; i < 4; ++i) cur[i] = nxt[i];
    }
}

typedef __bf16 bf2_t __attribute__((ext_vector_type(2)));
__device__ __forceinline__ float gelu_fast(float x) {
    const float u = x + 0.044715f * x * x * x;
    return x * __builtin_amdgcn_rcpf(1.0f + __builtin_amdgcn_exp2f(-2.3022082f * u));
}
struct Rows4 { u32x3 u[4], v[4]; };
__device__ __forceinline__ void peer_load4(Rows4& R, const unsigned char* __restrict__ U, const unsigned char* __restrict__ V, int epk, int g, int lane) {
    unsigned lo = 12u * (unsigned)lane; asm volatile("" : "+v"(lo));
#pragma unroll
    for (int j = 0; j < 4; ++j) {
        const int p = g * 4 + j;
        const unsigned e = ((unsigned)__builtin_amdgcn_readlane(epk, p & 63) >> ((p >> 6) << 4)) & 0xffffu;
        const unsigned off = e * 768u + lo;
        R.u[j] = *(const u32x3*)(U + off);
        R.v[j] = *(const u32x3*)(V + off);
    }
}
__device__ __forceinline__ f32x32 fp6x32(const u32x3 a, const u32x3 b) { const u32x6 w = {a.x, a.y, a.z, b.x, b.y, b.z}; return __builtin_amdgcn_cvt_scalef32_pk32_f32_fp6(w, 1.0f); }
__device__ __forceinline__ void peer_compute4(const Rows4& R, float* acc, const float* x, float rs, unsigned gpk, int g, int lane) {
    float d[4];
#pragma unroll
    for (int q = 0; q < 2; ++q) {
        const f32x32 uf = fp6x32(R.u[2 * q], R.u[2 * q + 1]);
        f32x2 s0 = {0.f, 0.f}, s1 = {0.f, 0.f};
#pragma unroll
        for (int i = 0; i < 16; i += 2) { const f32x2 xv = {x[i], x[i + 1]}; s0 = __builtin_elementwise_fma((f32x2){uf[i], uf[i + 1]}, xv, s0); s1 = __builtin_elementwise_fma((f32x2){uf[16 + i], uf[17 + i]}, xv, s1); }
        d[2 * q] = s0.x + s0.y; d[2 * q + 1] = s1.x + s1.y;
    }
    const bool b0 = (lane & 1) != 0, b1 = (lane & 2) != 0;
    const float k0 = b0 ? d[1] : d[0], s0 = b0 ? d[0] : d[1], k1 = b0 ? d[3] : d[2], s1 = b0 ? d[2] : d[3];
    const float e0 = k0 + dppmov<DPP_XOR1>(s0), e1 = k1 + dppmov<DPP_XOR1>(s1);
    const float kk = b1 ? e1 : e0, ss = b1 ? e0 : e1;
    float dj = kk + dppmov<DPP_XOR2>(ss);
    dj += dppmov<DPP_ROR4>(dj); dj += dppmov<DPP_ROR8>(dj); dj = swap32sum(swap16sum(dj));
    const int p = g * 4 + (lane & 3);
    const unsigned gr = (unsigned)__builtin_amdgcn_ds_bpermute((p & 63) << 2, (int)gpk);
    const float gt = __uint_as_float((gr >> ((g >> 4) << 4)) << 16);
    const float cf = gt * gelu_fast(dj * rs) * (1.0f / PEER_VSCALE);
#pragma unroll
    for (int q = 0; q < 2; ++q) {
        const float c0 = __uint_as_float(__builtin_amdgcn_readlane(__float_as_uint(cf), 2 * q)), c1 = __uint_as_float(__builtin_amdgcn_readlane(__float_as_uint(cf), 2 * q + 1));
        const f32x32 vf = fp6x32(R.v[2 * q], R.v[2 * q + 1]);
        const f32x2 c0v = {c0, c0}, c1v = {c1, c1};
#pragma unroll
        for (int i = 0; i < 16; i += 2) {
            f32x2 av = {acc[i], acc[i + 1]};
            av = __builtin_elementwise_fma(c0v, (f32x2){vf[i], vf[i + 1]}, av); av = __builtin_elementwise_fma(c1v, (f32x2){vf[16 + i], vf[17 + i]}, av);
            acc[i] = av.x; acc[i + 1] = av.y;
        }
    }
}
struct PeerMeta { u32x2 xq[4]; int i0, i1; float g0, g1, sq; };
__device__ __forceinline__ void peer_meta_load(PeerMeta& m, const WS& w, int t, int lane) {
#pragma unroll
    for (int k = 0; k < 4; ++k) m.xq[k] = *(const u32x2*)(w.xb1 + (size_t)t * DM + 256 * k + 4 * lane);
    m.i0 = w.pidx[(size_t)t * 128 + lane]; m.i1 = w.pidx[(size_t)t * 128 + 64 + lane];
    m.g0 = w.pgate[(size_t)t * 128 + lane]; m.g1 = w.pgate[(size_t)t * 128 + 64 + lane];
    m.sq = w.ssqp[(size_t)t * 16 + (lane & 15)];
}
__device__ __forceinline__ void peer_token_body(Rows4& X, Rows4& Y, Rows4& Z, PeerMeta& mn, const WS& w, const unsigned char* __restrict__ U, const unsigned char* __restrict__ V,
                                                const float* __restrict__ fin_g, float* __restrict__ out, int t, int tstep, int lane) {
    float xf[16];
#pragma unroll
    for (int k = 0; k < 4; ++k) { xf[4 * k] = lo_bf(mn.xq[k].x); xf[4 * k + 1] = hi_bf(mn.xq[k].x); xf[4 * k + 2] = lo_bf(mn.xq[k].y); xf[4 * k + 3] = hi_bf(mn.xq[k].y); }
    float rs; { float sq = mn.sq; sq += dppmov<DPP_XOR1>(sq); sq += dppmov<DPP_XOR2>(sq); sq += dppmov<DPP_ROR4>(sq); sq += dppmov<DPP_ROR8>(sq); rs = rsqrtf(sq * (1.0f / DM) + EPS) * (1.0f / PEER_USCALE); }
    const int epk = mn.i0 | (mn.i1 << 16);
    const unsigned gpk = pk2(mn.g0, mn.g1);
    const bool has_next = t + tstep < T;
    if (has_next) peer_meta_load(mn, w, t + tstep, lane);
    float acc[16];
#pragma unroll
    for (int i = 0; i < 16; ++i) acc[i] = 0.f;
    for (int g = 0; g < 30; g += 3) {
        peer_load4(Z, U, V, epk, g + 2, lane);
        peer_compute4(X, acc, xf, rs, gpk, g, lane);
        peer_load4(X, U, V, epk, g + 3, lane);
        peer_compute4(Y, acc, xf, rs, gpk, g + 1, lane);
        peer_load4(Y, U, V, epk, g + 4, lane);
        peer_compute4(Z, acc, xf, rs, gpk, g + 2, lane);
    }
    const int epn = mn.i0 | (mn.i1 << 16);
    if (has_next) peer_load4(Z, U, V, epn, 0, lane);
    peer_compute4(X, acc, xf, rs, gpk, 30, lane);
    if (has_next) peer_load4(X, U, V, epn, 1, lane);
    peer_compute4(Y, acc, xf, rs, gpk, 31, lane);
    float x[16]; float ss = 0.f;
#pragma unroll
    for (int i = 0; i < 16; ++i) { x[i] = xf[i] + acc[i]; ss += x[i] * x[i]; }
    ss = wave_sum(ss);
    const float rn = rsqrtf(ss * (1.0f / DM) + EPS);
    if (out) {
#pragma unroll
        for (int i = 0; i < 4; ++i) {
            const f32x4 ga = *(const f32x4*)(fin_g + 256 * i + 4 * lane);
            f32x4 a = {x[4 * i] * rn * ga[0], x[4 * i + 1] * rn * ga[1], x[4 * i + 2] * rn * ga[2], x[4 * i + 3] * rn * ga[3]};
            *(f32x4*)(out + (size_t)t * DM + 256 * i + 4 * lane) = a;
        }
    } else {
#pragma unroll
        for (int i = 0; i < 4; ++i) { u32x2 wq; wq.x = pk2(x[4 * i], x[4 * i + 1]); wq.y = pk2(x[4 * i + 2], x[4 * i + 3]); *(u32x2*)(w.xb + (size_t)t * DM + 256 * i + 4 * lane) = wq; }
        if (lane == 0) w.rs1[t] = rn;
    }
}
__device__ __forceinline__ void peer_fast_wave(const WS& w, int layer, const float* __restrict__ fin_g, float* __restrict__ out, int t0, int tstep, int lane) {
    const unsigned char* U = w.U8 + (size_t)layer * PE * 768; const unsigned char* V = w.V8 + (size_t)layer * PE * 768;
    if (t0 >= T) return;
    PeerMeta mn; peer_meta_load(mn, w, t0, lane);
    Rows4 A, B, C;
    { const int epk = mn.i0 | (mn.i1 << 16); peer_load4(A, U, V, epk, 0, lane); peer_load4(B, U, V, epk, 1, lane); }
    for (int t = t0; ; ) {
        peer_token_body(A, B, C, mn, w, U, V, fin_g, out, t, tstep, lane); t += tstep; if (t >= T) break;
        peer_token_body(C, A, B, mn, w, U, V, fin_g, out, t, tstep, lane); t += tstep; if (t >= T) break;
        peer_token_body(B, C, A, mn, w, U, V, fin_g, out, t, tstep, lane); t += tstep; if (t >= T) break;
    }
}

typedef float f32x16 __attribute__((ext_vector_type(16)));
__device__ __forceinline__ unsigned umax_(unsigned a, unsigned b) { return (unsigned)((int)a > (int)b ? (int)a : (int)b); }
__device__ __forceinline__ unsigned umin_(unsigned a, unsigned b) { return (unsigned)((int)a < (int)b ? (int)a : (int)b); }
__device__ __forceinline__ unsigned fkey(float v, unsigned mask, unsigned pay) {
    const unsigned u = __float_as_uint(v), k = u ^ ((unsigned)((int)u >> 31) & 0x7FFFFFFFu); return (k & ~mask) | pay; }
__device__ __forceinline__ float fkey_val(unsigned k, unsigned mask) { const unsigned v = k & ~mask; return __uint_as_float(v ^ ((unsigned)((int)v >> 31) & 0x7FFFFFFFu)); }
template <int N> __device__ __forceinline__ void bitonic_sort_desc(unsigned (&a)[N]) {
#pragma unroll
    for (int k = 2; k <= N; k <<= 1) {
#pragma unroll
        for (int j = k >> 1; j > 0; j >>= 1) {
#pragma unroll
            for (int i = 0; i < N; ++i) { const int l = i ^ j; if (l > i) { const bool desc = ((i & k) == 0);
                const unsigned hi = umax_(a[i], a[l]), lo = umin_(a[i], a[l]); a[i] = desc ? hi : lo; a[l] = desc ? lo : hi; } }
        }
    }
}
__device__ __forceinline__ void sort16_desc(unsigned (&a)[16]) {
#define CE16(i, j) { const unsigned hi_ = umax_(a[i], a[j]), lo_ = umin_(a[i], a[j]); a[i] = hi_; a[j] = lo_; }
    CE16(0, 13) CE16(1, 12) CE16(2, 15) CE16(3, 14) CE16(4, 8) CE16(5, 6) CE16(7, 11) CE16(9, 10)
    CE16(0, 5) CE16(1, 7) CE16(2, 9) CE16(3, 4) CE16(6, 13) CE16(8, 14) CE16(10, 15) CE16(11, 12)
    CE16(0, 1) CE16(2, 3) CE16(4, 5) CE16(6, 8) CE16(7, 9) CE16(10, 11) CE16(12, 13) CE16(14, 15)
    CE16(0, 2) CE16(1, 3) CE16(4, 10) CE16(5, 11) CE16(6, 7) CE16(8, 9) CE16(12, 14) CE16(13, 15)
    CE16(1, 2) CE16(3, 12) CE16(4, 6) CE16(5, 7) CE16(8, 10) CE16(9, 11) CE16(13, 14)
    CE16(1, 4) CE16(2, 6) CE16(5, 8) CE16(7, 10) CE16(9, 13) CE16(11, 14)
    CE16(2, 4) CE16(3, 6) CE16(9, 12) CE16(11, 13)
    CE16(3, 5) CE16(6, 8) CE16(7, 9) CE16(10, 12)
    CE16(3, 4) CE16(5, 6) CE16(7, 8) CE16(9, 10) CE16(11, 12)
    CE16(6, 7) CE16(8, 9)
#undef CE16
}
template <int N> __device__ __forceinline__ void bitonic_merge_desc(unsigned (&a)[N]) {
#pragma unroll
    for (int j = N >> 1; j > 0; j >>= 1) {
#pragma unroll
        for (int i = 0; i < N; ++i) { const int l = i ^ j; if (l > i) { const unsigned hi = umax_(a[i], a[l]), lo = umin_(a[i], a[l]); a[i] = hi; a[l] = lo; } }
    }
}
__device__ __forceinline__ void top16_merge(unsigned (&a)[16], const unsigned (&b)[16]) {
#pragma unroll
    for (int i = 0; i < 16; ++i) a[i] = umax_(a[i], b[15 - i]);
    bitonic_merge_desc<16>(a);
}
__device__ __forceinline__ void top16_xlane(unsigned (&a)[16], int hh) {
    unsigned lo[16], up[16];
#pragma unroll
    for (int i = 0; i < 16; ++i) { const auto r = __builtin_amdgcn_permlane32_swap(a[i], a[i], false, false); lo[i] = r[0]; up[i] = r[1]; }
#pragma unroll
    for (int i = 0; i < 16; ++i) a[i] = umax_(lo[i], up[15 - i]);
    bitonic_merge_desc<16>(a);
    (void)hh;
}
constexpr int RT_SKP = 272;
constexpr int RT_SK_BYTES = 256 * RT_SKP;
struct RouteQ { bf16x8 f[2][8]; };
__device__ __forceinline__ void route_load_q(RouteQ& q, const WS& w, int tb, int h, int col, int hh) {
    const bf16_t* qb = w.q + ((size_t)((tb * 8 + h) * 2) * 8 * 64 + col + 32 * hh) * 8;
#pragma unroll
    for (int c = 0; c < 2; ++c)
#pragma unroll
        for (int ks = 0; ks < 8; ++ks) q.f[c][ks] = *(const bf16x8*)(qb + (c * 8 + ks) * 512);
}
__device__ __forceinline__ void route_scores(f32x16 (&acc)[4], const LAS unsigned char* skl, const bf16x8 (&qf)[8], int c, int col, int hh) {
#pragma unroll
    for (int kt = 0; kt < 4; ++kt)
#pragma unroll
        for (int r = 0; r < 16; ++r) acc[kt][r] = 0.f;
    const LAS unsigned char* sk = skl + (c * PK + col) * RT_SKP + 16 * hh;
#pragma unroll
    for (int ks = 0; ks < 8; ++ks) {
#pragma unroll
        for (int kt = 0; kt < 4; ++kt) {
            const bf16x8 a = *(const LAS bf16x8*)(sk + kt * 32 * RT_SKP + 32 * ks);
            acc[kt] = __builtin_amdgcn_mfma_f32_32x32x16_bf16(a, qf[ks], acc[kt], 0, 0, 0);
        }
    }
}
__device__ __forceinline__ void route_top16(unsigned (&g0)[16], const f32x16 (&acc)[4], int hh) {
    asm volatile("" : "+v"(hh));
    unsigned g1[16], g2[16], g3[16];
#pragma unroll
    for (int r = 0; r < 16; ++r) {
        const unsigned kb = 8 * (r >> 2) + 4 * hh + (r & 3);
        g0[r] = fkey(acc[0][r], 0x7Fu, 127u - kb); g1[r] = fkey(acc[1][r], 0x7Fu, 127u - (32u + kb));
        g2[r] = fkey(acc[2][r], 0x7Fu, 127u - (64u + kb)); g3[r] = fkey(acc[3][r], 0x7Fu, 127u - (96u + kb));
    }
    sort16_desc(g0); sort16_desc(g1); sort16_desc(g2); sort16_desc(g3);
    top16_merge(g0, g1); top16_merge(g2, g3); top16_merge(g0, g2);
    top16_xlane(g0, hh);
}
__device__ __forceinline__ void route_fast_unit(const WS& w, const LAS unsigned char* skl, RouteQ& qf, int tb, int tbn, int h, int lane, volatile __attribute__((address_space(3))) unsigned* ldsw) {
    const int col = lane & 31, hh = lane >> 5;
    const int t = tb * 32 + col;
    unsigned top0[16], top1[16];
    { f32x16 acc[4]; route_scores(acc, skl, qf.f[0], 0, col, hh); route_top16(top0, acc, hh); }
    { f32x16 acc[4]; route_scores(acc, skl, qf.f[1], 1, col, hh);
      if (tbn >= 0) route_load_q(qf, w, tbn, h, col, hh);
      __builtin_amdgcn_sched_barrier(0);
      route_top16(top1, acc, hh); }
    float v0[16], v1[16];
#pragma unroll
    for (int i = 0; i < 16; ++i) { v0[i] = fkey_val(top0[i], 0x7Fu); v1[i] = fkey_val(top1[i], 0x7Fu); }
    unsigned ca[16], cb[16];
#pragma unroll
    for (int i = 0; i < 16; ++i) { ca[i] = 0x80000000u; cb[i] = 0x80000000u; }
#define CAND(s, a0, b0, a1, b1) { const float sv = hh ? (v0[a1] + v1[b1]) : (v0[a0] + v1[b0]); const unsigned pay = 255u - (unsigned)(hh ? (a1 * 16 + b1) : (a0 * 16 + b0)); \
        if ((s) < 16) ca[(s) & 15] = fkey(sv, 0xFFu, pay); else cb[(s) & 15] = fkey(sv, 0xFFu, pay); }
    CAND(0, 0, 0, 0, 1); CAND(1, 0, 2, 0, 3); CAND(2, 0, 4, 0, 5); CAND(3, 0, 6, 0, 7); CAND(4, 0, 8, 0, 9); CAND(5, 0, 10, 0, 11); CAND(6, 0, 12, 0, 13); CAND(7, 0, 14, 0, 15);
    CAND(8, 1, 0, 1, 1); CAND(9, 1, 2, 1, 3); CAND(10, 1, 4, 1, 5); CAND(11, 1, 6, 1, 7); CAND(12, 2, 0, 2, 1); CAND(13, 2, 2, 2, 3); CAND(14, 2, 4, 3, 0); CAND(15, 3, 1, 3, 2);
    CAND(16, 3, 3, 4, 0); CAND(17, 4, 1, 4, 2); CAND(18, 5, 0, 5, 1); CAND(19, 6, 0, 6, 1); CAND(20, 7, 0, 7, 1); CAND(21, 8, 0, 9, 0); CAND(22, 10, 0, 11, 0); CAND(23, 12, 0, 13, 0); CAND(24, 14, 0, 15, 0);
#undef CAND
    sort16_desc(ca); sort16_desc(cb);
    top16_merge(ca, cb);
    top16_xlane(ca, hh);
    volatile __attribute__((address_space(3))) unsigned* mine = ldsw + lane * 9;
#pragma unroll
    for (int j = 0; j < 4; ++j) {
        mine[j] = (127u - (top0[4 * j] & 127u)) | ((127u - (top0[4 * j + 1] & 127u)) << 8) | ((127u - (top0[4 * j + 2] & 127u)) << 16) | ((127u - (top0[4 * j + 3] & 127u)) << 24);
        mine[4 + j] = (127u - (top1[4 * j] & 127u)) | ((127u - (top1[4 * j + 1] & 127u)) << 8) | ((127u - (top1[4 * j + 2] & 127u)) << 16) | ((127u - (top1[4 * j + 3] & 127u)) << 24);
    }
    volatile __attribute__((address_space(3))) unsigned char* tb8 = (volatile __attribute__((address_space(3))) unsigned char*)mine;
    int ex[16]; float ev[16];
    const float vmax = fkey_val(ca[0], 0xFFu);
    float esum = 0.f;
#pragma unroll
    for (int r = 0; r < 16; ++r) {
        const unsigned pay = 255u - (ca[r] & 255u);
        const int ia = tb8[pay >> 4], ib = tb8[16 + (pay & 15u)];
        ex[r] = ia * PK + ib;
        ev[r] = __builtin_amdgcn_exp2f((fkey_val(ca[r], 0xFFu) - vmax) * 1.4426950408889634f);
        esum += ev[r];
    }
    const float inv = 1.0f / esum;
    int* pi = w.pidx + (size_t)t * 128 + h * PTOP + 8 * hh; float* pg = w.pgate + (size_t)t * 128 + h * PTOP + 8 * hh;
    typedef int i32x4 __attribute__((ext_vector_type(4)));
    i32x4 i0, i1; f32x4 gg0, gg1;
#pragma unroll
    for (int j = 0; j < 4; ++j) {
        int ea = ex[j], eb = ex[8 + j], ec = ex[4 + j], ed = ex[12 + j]; float fa = ev[j], fb = ev[8 + j], fc = ev[4 + j], fd = ev[12 + j];
        asm volatile("" : "+v"(ea), "+v"(eb), "+v"(ec), "+v"(ed), "+v"(fa), "+v"(fb), "+v"(fc), "+v"(fd));
        i0[j] = hh ? eb : ea; i1[j] = hh ? ed : ec; gg0[j] = (hh ? fb : fa) * inv; gg1[j] = (hh ? fd : fc) * inv; }
    *(i32x4*)pi = i0; *(i32x4*)(pi + 4) = i1; *(f32x4*)pg = gg0; *(f32x4*)(pg + 4) = gg1;
}


constexpr int AT_KP = 144, AT_VP = 136, AT_KBYTES = 64 * AT_KP, AT_BUF = 64 * AT_KP + 64 * AT_VP;
constexpr int AT_OSTP = 144, AT_OST = 6 * AT_BUF;
typedef unsigned short LAS lds_bf16;
__device__ __forceinline__ float vmax3(float a, float b, float c) { return fmaxf(fmaxf(a, b), c); }
struct AttnOut { bf16_t* cat; bf16_t* dilO; float* dilL; const float* subg; float lam, lam_init; int layer; };
template <int MODE, bool RES = false, bool DUAL = false>
__device__ __forceinline__ void attn_unit(LAS unsigned char* lds, const bf16_t* __restrict__ proj, int qcol, int kcol, int vcol, int rowbase_a, int rstep,
                                          int i0, int nq, int kstart, int ntiles, int W, const AttnOut& ao, int ocol, int tid, int rowbase2 = 0) {
    constexpr int NM = (MODE == 0) ? 2 : 1;
    const int lane = tid & 63, wv = __builtin_amdgcn_readfirstlane(tid >> 6), col = lane & 31, hh = lane >> 5;
    const int wq = DUAL ? (wv & 3) : wv, jlo = (DUAL && wv >= 4) ? 2 : 0, rowbase = (DUAL && wv >= 4) ? rowbase2 : rowbase_a;
    const int a0 = i0 + 32 * wq; const bool active = (32 * wq < nq);
    const int qi = a0 + col;
    const float sl2 = ((MODE == 0) ? 0.17677669529663687f : 0.125f) * 1.4426950408889634f;
    bf16x8 qf[4];
    { const bf16_t* qp = proj + (size_t)(rowbase + rstep * (active ? qi : i0)) * INW + qcol + 8 * hh;
#pragma unroll
      for (int ks = 0; ks < 4; ++ks) qf[ks] = *(const bf16x8*)(qp + 16 * ks); }
    f32x16 O[NM][2]; float mrun[NM], lsum[NM];
#pragma unroll
    for (int m = 0; m < NM; ++m) { mrun[m] = -1e30f; lsum[m] = 0.f;
#pragma unroll
        for (int mt = 0; mt < 2; ++mt)
#pragma unroll
            for (int r = 0; r < 16; ++r) O[m][mt][r] = 0.f; }
    const int srow = tid >> 3, spiece = tid & 7;
    u32x4 kreg, vreg;
#define AT_LOAD(j) do { const bf16_t* rp = proj + (size_t)(rowbase_a + rstep * (kstart + 64 * (j) + srow)) * INW + 8 * spiece; \
        kreg = *(const u32x4*)(rp + kcol); vreg = *(const u32x4*)(rp + vcol); } while (0)
#define AT_WRITE(buf) do { LAS unsigned char* B_ = lds + (buf) * AT_BUF; *(LAS u32x4*)(B_ + srow * AT_KP + spiece * 16) = kreg; \
        lds_bf16* vt_ = (lds_bf16*)(B_ + AT_KBYTES) + (8 * spiece) * (AT_VP / 2) + srow; \
        vt_[0 * (AT_VP / 2)] = (bf16_t)(vreg.x & 0xffffu); vt_[1 * (AT_VP / 2)] = (bf16_t)(vreg.x >> 16); vt_[2 * (AT_VP / 2)] = (bf16_t)(vreg.y & 0xffffu); vt_[3 * (AT_VP / 2)] = (bf16_t)(vreg.y >> 16); \
        vt_[4 * (AT_VP / 2)] = (bf16_t)(vreg.z & 0xffffu); vt_[5 * (AT_VP / 2)] = (bf16_t)(vreg.z >> 16); vt_[6 * (AT_VP / 2)] = (bf16_t)(vreg.w & 0xffffu); vt_[7 * (AT_VP / 2)] = (bf16_t)(vreg.w >> 16); } while (0)
    if (RES) {
        u32x4 kr[6], vr[6];
#pragma unroll
        for (int j = 0; j < 6; ++j) if (j < ntiles) { const int rb_ = (DUAL && j >= 2) ? rowbase2 : rowbase_a, kt_ = DUAL ? (j & 1) : j;
            const bf16_t* rp = proj + (size_t)(rb_ + rstep * (kstart + 64 * kt_ + srow)) * INW + 8 * spiece; kr[j] = *(const u32x4*)(rp + kcol); vr[j] = *(const u32x4*)(rp + vcol); }
#pragma unroll
        for (int j = 0; j < 6; ++j) if (j < ntiles) { kreg = kr[j]; vreg = vr[j]; AT_WRITE(j); }
    } else { AT_LOAD(0); AT_WRITE(0); }
    __syncthreads();
    for (int j = jlo; j < (DUAL ? jlo + 2 : ntiles); ++j) {
        if (!RES && j + 1 < ntiles) AT_LOAD(j + 1);
        const LAS unsigned char* Kb = lds + (RES ? j : (j & 1)) * AT_BUF; const LAS unsigned char* Vb = Kb + AT_KBYTES;
        const int k0 = kstart + 64 * (DUAL ? (j - jlo) : j);
#pragma unroll
        for (int sb = 0; sb < 2; ++sb) {
            const int ks0 = k0 + 32 * sb;
            if (active && ks0 <= a0 + 31 && ks0 + 31 >= a0 - W) {
#pragma unroll
                for (int m = 0; m < NM; ++m) {
                    f32x16 s;
#pragma unroll
                    for (int r = 0; r < 16; ++r) s[r] = 0.f;
#pragma unroll
                    for (int ks = 0; ks < 4 / NM; ++ks) {
                        const int kq = (MODE == 0) ? (2 * m + ks) : ks;
                        const bf16x8 af = *(const LAS bf16x8*)(Kb + (32 * sb + col) * AT_KP + (16 * kq + 8 * hh) * 2);
                        s = __builtin_amdgcn_mfma_f32_32x32x16_bf16(af, qf[kq], s, 0, 0, 0);
                    }
                    const bool masked = (ks0 + 31 > a0) || (ks0 < a0 + 31 - W);
                    if (masked) {
                        const int dq = qi - ks0 - 4 * hh;
#pragma unroll
                        for (int r = 0; r < 16; ++r) {
                            const int off = 8 * (r >> 2) + (r & 3);
                            const bool valid = (off <= dq) && (off >= dq - W);
                            s[r] = valid ? s[r] : -1e30f;
                        }
                    }
                    float mx = vmax3(s[0], s[1], s[2]);
                    mx = vmax3(mx, s[3], s[4]); mx = vmax3(mx, s[5], s[6]); mx = vmax3(mx, s[7], s[8]); mx = vmax3(mx, s[9], s[10]);
                    mx = vmax3(mx, s[11], s[12]); mx = vmax3(mx, s[13], s[14]); mx = fmaxf(mx, s[15]);
                    { const auto sw = __builtin_amdgcn_permlane32_swap(__float_as_uint(mx), __float_as_uint(mx), false, false);
                      mx = fmaxf(__uint_as_float(sw[0]), __uint_as_float(sw[1])); }
                    mx = mx * sl2;
                    if (__any(mx > mrun[m])) {
                        const float mnew = (mx > mrun[m]) ? mx : mrun[m], alpha = __builtin_amdgcn_exp2f(mrun[m] - mnew);
                        mrun[m] = mnew; lsum[m] *= alpha;
#pragma unroll
                        for (int mt = 0; mt < 2; ++mt)
#pragma unroll
                            for (int r = 0; r < 16; ++r) O[m][mt][r] *= alpha;
                    }
                    {
                        const f32x2 sl2v = {sl2, sl2}, mnegv = {-mrun[m], -mrun[m]};
                        f32x2 ps = {0.f, 0.f};
#pragma unroll
                        for (int r = 0; r < 16; r += 2) {
                            const f32x2 a2 = (f32x2){s[r], s[r + 1]} * sl2v + mnegv;
                            const float p0 = __builtin_amdgcn_exp2f(a2.x), p1 = __builtin_amdgcn_exp2f(a2.y);
                            s[r] = p0; s[r + 1] = p1; ps += (f32x2){p0, p1};
                        }
                        lsum[m] += ps.x + ps.y;
                    }
#pragma unroll
                    for (int st = 0; st < 2; ++st) {
                        u32x4 pw; pw.x = pk2(s[8 * st], s[8 * st + 1]); pw.y = pk2(s[8 * st + 2], s[8 * st + 3]); pw.z = pk2(s[8 * st + 4], s[8 * st + 5]); pw.w = pk2(s[8 * st + 6], s[8 * st + 7]);
                        const bf16x8 pf = __builtin_bit_cast(bf16x8, pw);
#pragma unroll
                        for (int mt = 0; mt < 2; ++mt) {
                            const LAS unsigned char* vp = Vb + (32 * mt + col) * AT_VP + (32 * sb + 16 * st + 4 * hh) * 2;
                            const u32x2 lo = *(const LAS u32x2*)vp, hi = *(const LAS u32x2*)(vp + 16);
                            u32x4 vw; vw.x = lo.x; vw.y = lo.y; vw.z = hi.x; vw.w = hi.y;
                            O[m][mt] = __builtin_amdgcn_mfma_f32_32x32x16_bf16(__builtin_bit_cast(bf16x8, vw), pf, O[m][mt], 0, 0, 0);
                        }
                    }
                }
            }
        }
        if (!RES) { if (j + 1 < ntiles) AT_WRITE((j + 1) & 1); __syncthreads(); }
    }
    if (RES) __syncthreads();
#undef AT_LOAD
#undef AT_WRITE
    if (active) {
        const size_t row = (size_t)(rowbase + rstep * qi);
        LAS unsigned char* ost = lds + AT_OST + wv * (32 * AT_OSTP);
#define AT_FLUSH(base, ld) { _Pragma("unroll") for (int i_ = 0; i_ < 4; ++i_) { const int qq_ = 8 * i_ + (lane >> 3), ch_ = lane & 7; \
            const u32x4 v_ = *(const LAS u32x4*)(ost + qq_ * AT_OSTP + ch_ * 16); \
            *(u32x4*)((base) + (size_t)(rowbase + rstep * (a0 + qq_)) * (ld) + ocol + 8 * ch_) = v_; } }
        if (MODE == 0) {
            const float l0 = lsum[0] + __shfl_xor(lsum[0], 32), l1 = lsum[NM - 1] + __shfl_xor(lsum[NM - 1], 32);
            const float i0v = 1.0f / l0, i1v = ao.lam / l1;
            float ss = 0.f;
#pragma unroll
            for (int mt = 0; mt < 2; ++mt)
#pragma unroll
                for (int r = 0; r < 16; ++r) { const float o = O[0][mt][r] * i0v - O[NM - 1][mt][r] * i1v; O[0][mt][r] = o; ss += o * o; }
            ss += __shfl_xor(ss, 32);
            const float rn = rsqrtf(ss * (1.0f / 64.0f) + EPS) * (1.0f - ao.lam_init);
            f32x4 sgv[8];
#pragma unroll
            for (int j = 0; j < 8; ++j) sgv[j] = *(const f32x4*)(ao.subg + ao.layer * 64 + 32 * (j >> 2) + 8 * (j & 3) + 4 * hh);
            __builtin_amdgcn_sched_barrier(0);
#pragma unroll
            for (int mt = 0; mt < 2; ++mt)
#pragma unroll
                for (int g = 0; g < 4; ++g) {
                    const int d0 = 32 * mt + 8 * g + 4 * hh;
                    const f32x4 sg = sgv[mt * 4 + g];
                    u32x2 wv2; wv2.x = pk2(O[0][mt][4 * g] * rn * sg[0], O[0][mt][4 * g + 1] * rn * sg[1]); wv2.y = pk2(O[0][mt][4 * g + 2] * rn * sg[2], O[0][mt][4 * g + 3] * rn * sg[3]);
                    *(LAS u32x2*)(ost + col * AT_OSTP + d0 * 2) = wv2;
                }
            AT_FLUSH(ao.cat, DM)
        } else {
            const float l0 = lsum[0] + __shfl_xor(lsum[0], 32), inv = 1.0f / l0;
#pragma unroll
            for (int mt = 0; mt < 2; ++mt)
#pragma unroll
                for (int g = 0; g < 4; ++g) {
                    const int d0 = 32 * mt + 8 * g + 4 * hh;
                    u32x2 wv2; wv2.x = pk2(O[0][mt][4 * g] * inv, O[0][mt][4 * g + 1] * inv); wv2.y = pk2(O[0][mt][4 * g + 2] * inv, O[0][mt][4 * g + 3] * inv);
                    *(LAS u32x2*)(ost + col * AT_OSTP + d0 * 2) = wv2;
                }
            AT_FLUSH(ao.dilO, DILW)
            if (hh == 0) ao.dilL[row * DILH + (ocol >> 6)] = (mrun[0] + __builtin_amdgcn_logf(l0)) * 0.6931471805599453f;
        }
#undef AT_FLUSH
    }
}
constexpr int N_ATTN_UNITS = 1408;
constexpr int A_DEFER = 3;
__device__ __forceinline__ void attn_dispatch(LAS unsigned char* lds, const WS& w, int u, AttnOut ao, int tid) {
    if (u < 256) {
        const int qb = 7 - (u >> 5), bh = u & 31, b = bh >> 2, h = bh & 3;
        attn_unit<0>(lds, w.proj, OFF_FQ + h * 64, OFF_FK + h * 64, OFF_FV + h * 64, b * SEQ, 1, 256 * qb, 256, 0, 4 * (qb + 1), 1 << 30, ao, 768 + h * 64, tid);
    } else if (u < 640) {
        const int v = u - 256, qb = 7 - v / 48, bh = v % 48, b = bh / 6, hd = bh % 6;
        const int i0 = 256 * qb, ks = (i0 >= 128) ? i0 - 128 : 0;
        ao.dilO = w.dilO; ao.dilL = w.dilL;
        attn_unit<1, true>(lds, w.proj, OFF_DQ + hd * 64, OFF_DK + hd * 64, OFF_DV + hd * 64, b * SEQ, 1, i0, 256, ks, (i0 + 256 - ks) / 64, 128, ao, hd * 64, tid);
    } else if (u < 1024) {
        const int v = u - 640, qb = 1 - v / 192, rr = (v % 192) / 48, bh = v % 48, b = bh / 6, hd = bh % 6;
        const int i0 = 256 * qb, ks = (i0 >= 128) ? i0 - 128 : 0;
        ao.dilO = w.dilO + (size_t)T * DILW; ao.dilL = w.dilL + (size_t)T * DILH;
        attn_unit<1, true>(lds, w.proj, OFF_DQ + hd * 64, OFF_DK + hd * 64, OFF_DV + hd * 64, b * SEQ + rr, 4, i0, 256, ks, (i0 + 256 - ks) / 64, 128, ao, hd * 64, tid);
    } else {
        const int v = u - 1024, rr = v / 48, bh = v % 48, b = bh / 6, hd = bh % 6;
        ao.dilO = w.dilO + (size_t)2 * T * DILW; ao.dilL = w.dilL + (size_t)2 * T * DILH;
        attn_unit<1, true, true>(lds, w.proj, OFF_DQ + hd * 64, OFF_DK + hd * 64, OFF_DV + hd * 64, b * SEQ + rr, 16, 0, 128, 0, 4, 128, ao, hd * 64, tid, b * SEQ + rr + 8);
    }
}


constexpr int S5_KT = 64 * 256, S5_W = 64 * 128 * 16;
struct S5Tab { bf16_t *Ktab, *Wend, *Wout; const float *lam_re, *lam_im, *log_step; };
constexpr int NTHR_C = 512;
__device__ __forceinline__ f32x2 cmul(f32x2 a, f32x2 b) { return (f32x2){a.x * b.x - a.y * b.y, a.x * b.y + a.y * b.x}; }
__device__ __forceinline__ void s5_prep_task(LAS unsigned char* lds, const S5Tab& st, const float* __restrict__ lam_re, const float* __restrict__ lam_im, const float* __restrict__ log_step,
                                             const float* __restrict__ b_re, const float* __restrict__ b_im, const float* __restrict__ c_re, const float* __restrict__ c_im,
                                             const float* __restrict__ dsk, int lg, int oct, int tid) {
    LAS f32x2* PwL = (LAS f32x2*)lds;
    LAS f32x2* BbL = PwL + 9 * 64;
    LAS f32x2* CL = BbL + 64 * 16;
    const float dt = expf(log_step[lg]);
    for (int i = tid; i < 9 * 64; i += NTHR_C) {
        const int p = i & 63; const float n = (float)(8 * oct + (i >> 6));
        const float lr = lam_re[(size_t)lg * NS + p], li = lam_im[(size_t)lg * NS + p];
        const float mag = __expf(lr * dt * n), ang = li * dt * n;
        PwL[i] = (f32x2){mag * __cosf(ang), mag * __sinf(ang)};
    }
    for (int i = tid; i < 64 * 16; i += NTHR_C) {
        const int p = i >> 4; const size_t lgp = (size_t)lg * NS + p;
        const float lr = lam_re[lgp], li = lam_im[lgp];
        const float mag = __expf(lr * dt), lbr = mag * __cosf(li * dt), lbi = mag * __sinf(li * dt);
        const float nr = lbr - 1.0f, ni = lbi, den = lr * lr + li * li;
        const f32x2 kap = {(nr * lr + ni * li) / den, (ni * lr - nr * li) / den};
        BbL[i] = cmul(kap, (f32x2){b_re[(size_t)lg * NS * GC + i], b_im[(size_t)lg * NS * GC + i]});
        CL[i] = (f32x2){c_re[(size_t)lg * GC * NS + i], c_im[(size_t)lg * GC * NS + i]};
    }
    __syncthreads();
    {
        LAS f32x2* TL = CL + 16 * 64;
        for (int i = tid; i < 8 * 64 * 16; i += NTHR_C) { const int ci_ = i & 15, p_ = (i >> 4) & 63, jj_ = i >> 10; TL[i] = cmul(PwL[jj_ * 64 + p_], BbL[p_ * 16 + ci_]); }
        __syncthreads();
        const int ci = tid & 15, co = (tid >> 4) & 15, jj0 = tid >> 8;
        float s[4] = {0.f, 0.f, 0.f, 0.f};
        for (int p = 0; p < NS; ++p) {
            const f32x2 cc = CL[co * 64 + p];
#pragma unroll
            for (int q = 0; q < 4; ++q) { const f32x2 m = TL[((jj0 + 2 * q) * 64 + p) * 16 + ci]; s[q] += cc.x * m.x - cc.y * m.y; }
        }
#pragma unroll
        for (int q = 0; q < 4; ++q) {
            const int j = 8 * oct + jj0 + 2 * q;
            const float v = s[q] + ((j == 0 && co == ci) ? dsk[(size_t)lg * GC + co] : 0.f);
            st.Ktab[(size_t)lg * S5_KT + (j * 16 + co) * 16 + ci] = f2bf(v);
        }
    }
    for (int i = tid; i < 2048; i += NTHR_C) {
        const int ch = i & 1, rho = (i >> 1) & 127, jj = i >> 8, p = rho & 63, sg = 63 - (8 * oct + jj);
        const f32x2 pw = PwL[jj * 64 + p];
        float v[8];
#pragma unroll
        for (int c = 0; c < 8; ++c) { const f32x2 z = cmul(pw, BbL[p * 16 + 8 * ch + c]); v[c] = (rho < 64) ? z.x : z.y; }
        u32x4 w; w.x = pk2(v[0], v[1]); w.y = pk2(v[2], v[3]); w.z = pk2(v[4], v[5]); w.w = pk2(v[6], v[7]);
        *(u32x4*)(st.Wend + (size_t)lg * S5_W + ((size_t)(sg * 128 + rho) * 16 + 8 * ch)) = w;
    }
    for (int i = tid; i < 2048; i += NTHR_C) {
        const int r8 = i & 15, co = (i >> 4) & 15, jj = i >> 8, tau = 8 * oct + jj;
        float v[8];
#pragma unroll
        for (int e = 0; e < 8; ++e) { const int rho = 8 * r8 + e, p = rho & 63; const f32x2 z = cmul(CL[co * 64 + p], PwL[(jj + 1) * 64 + p]); v[e] = (rho < 64) ? z.x : -z.y; }
        u32x4 w; w.x = pk2(v[0], v[1]); w.y = pk2(v[2], v[3]); w.z = pk2(v[4], v[5]); w.w = pk2(v[6], v[7]);
        *(u32x4*)(st.Wout + (size_t)lg * S5_W + ((size_t)(((tau >> 1) * 8 + (r8 >> 1)) * 64 + (tau & 1) * 16 + co + 32 * (r8 & 1)) * 8)) = w;
    }
    __syncthreads();
}
constexpr int S5_EP = 33;
constexpr int S5_LDS_U = 0, S5_LDS_K = 65536, S5_LDS_E = 65536 + 32768, S5_LDS_X = S5_LDS_E + 256 * S5_EP * 4;
__device__ __forceinline__ void s5_unit(LAS unsigned char* lds, const WS& w, const S5Tab& st, int layer, int b, int g, int tid) {
    const int lane = tid & 63, wv = __builtin_amdgcn_readfirstlane(tid >> 6), col = lane & 31, hh = lane >> 5;
    const size_t lg = (size_t)layer * NG + g;
#pragma unroll
    for (int i = 0; i < 8; ++i) {
        const int q = tid + 512 * i, t = q >> 1, half = q & 1;
        const u32x4 v = *(const u32x4*)(w.proj + (size_t)(b * SEQ + t) * INW + g * GC + 8 * half);
        *(LAS u32x4*)(lds + S5_LDS_U + (((t & 63) * 32 + (t >> 6)) * 16 + 8 * half) * 2) = v;
    }
#pragma unroll
    for (int i = 0; i < 4; ++i) { const int q = tid + 512 * i; *(LAS u32x4*)(lds + S5_LDS_K + q * 16) = *(const u32x4*)(st.Ktab + lg * S5_KT + q * 8); }
    __syncthreads();
    {
        const int mt = wv & 3, sh = wv >> 2;
        f32x16 acc;
#pragma unroll
        for (int r = 0; r < 16; ++r) acc[r] = 0.f;
        const bf16_t* wp = st.Wend + lg * S5_W + (size_t)(32 * mt + col) * 16 + 8 * hh + (size_t)(32 * sh) * 128 * 16;
        bf16x8 wa[2][8];
#define S5_LOADW(buf, bt) { _Pragma("unroll") for (int j = 0; j < 8; ++j) wa[buf][j] = *(const bf16x8*)(wp + (size_t)(8 * (bt) + j) * 128 * 16); }
        S5_LOADW(0, 0)
#pragma unroll
        for (int bt = 0; bt < 4; ++bt) {
            if (bt + 1 < 4) S5_LOADW((bt + 1) & 1, bt + 1)
            __builtin_amdgcn_sched_barrier(0);
#pragma unroll
            for (int j = 0; j < 8; ++j) {
                const int sg = 32 * sh + 8 * bt + j;
                const bf16x8 bfv = *(const LAS bf16x8*)(lds + S5_LDS_U + ((sg * 32 + col) * 16 + 8 * hh) * 2);
                acc = __builtin_amdgcn_mfma_f32_32x32x16_bf16(wa[bt & 1][j], bfv, acc, 0, 0, 0);
            }
            __builtin_amdgcn_sched_barrier(0);
        }
#undef S5_LOADW
        LAS float* E = (LAS float*)(lds + S5_LDS_E);
#pragma unroll
        for (int r = 0; r < 16; ++r) E[(sh * 128 + 32 * mt + 8 * (r >> 2) + 4 * hh + (r & 3)) * S5_EP + col] = acc[r];
    }
    __syncthreads();
    if (tid < NS) {
        const int p = tid;
        f32x2 l64; { const float dt = __expf(st.log_step[lg]) * 64.0f, mag = __expf(st.lam_re[lg * NS + p] * dt), ang = st.lam_im[lg * NS + p] * dt; l64 = (f32x2){mag * __cosf(ang), mag * __sinf(ang)}; }
        const LAS float* E = (const LAS float*)(lds + S5_LDS_E);
        lds_bf16* X = (lds_bf16*)(lds + S5_LDS_X);
        f32x2 x = {0.f, 0.f};
#pragma unroll 1
        for (int kb = 0; kb < 32; kb += 8) {
            f32x2 e[8];
#pragma unroll
            for (int j = 0; j < 8; ++j) e[j] = (f32x2){E[p * S5_EP + kb + j] + E[(128 + p) * S5_EP + kb + j], E[(64 + p) * S5_EP + kb + j] + E[(128 + 64 + p) * S5_EP + kb + j]};
#pragma unroll
            for (int j = 0; j < 8; ++j) {
                const int k = kb + j;
                X[((p >> 4) * 32 + k) * 16 + (p & 15)] = f2bf(x.x);
                X[((4 + (p >> 4)) * 32 + k) * 16 + (p & 15)] = f2bf(x.y);
                x = cmul(l64, x); x.x += e[j].x; x.y += e[j].y;
            }
        }
    }
    __syncthreads();
    bf16x8 wo8[8];
    { const bf16_t* wo = st.Wout + lg * S5_W + ((size_t)(wv * 8) * 64 + lane) * 8;
#pragma unroll
      for (int ks = 0; ks < 8; ++ks) wo8[ks] = *(const bf16x8*)(wo + ks * 512); }
#pragma unroll 1
    for (int q = 0; q < 4; ++q) {
        const int i = (q == 0) ? wv : (q == 1) ? 31 - wv : (q == 2) ? wv + 8 : 23 - wv;
        f32x16 acc;
#pragma unroll
        for (int r = 0; r < 16; ++r) acc[r] = 0.f;
        const int tl = col >> 4, co = col & 15;
#pragma unroll
        for (int ks = 0; ks < 8; ++ks) {
            const bf16x8 bfv = *(const LAS bf16x8*)(lds + S5_LDS_X + ((ks * 32 + col) * 16 + 8 * hh) * 2);
            acc = __builtin_amdgcn_mfma_f32_32x32x16_bf16(wo8[ks], bfv, acc, 0, 0, 0);
        }
        if (q < 3) {
            const int in_ = (q == 0) ? 31 - wv : (q == 1) ? wv + 8 : 23 - wv;
            const bf16_t* wo = st.Wout + lg * S5_W + ((size_t)(in_ * 8) * 64 + lane) * 8;
#pragma unroll
            for (int ks = 0; ks < 8; ++ks) wo8[ks] = *(const bf16x8*)(wo + ks * 512);
        }
        __builtin_amdgcn_sched_barrier(0);
        for (int sg = 0; sg <= 2 * i + 1; ++sg) {
            const int lag = 2 * i + tl - sg;
            bf16x8 af = *(const LAS bf16x8*)(lds + S5_LDS_K + (((lag < 0 ? 0 : lag) * 16 + co) * 16 + 8 * hh) * 2);
            if (lag < 0) af = (bf16x8){0, 0, 0, 0, 0, 0, 0, 0};
            const bf16x8 bfv = *(const LAS bf16x8*)(lds + S5_LDS_U + ((sg * 32 + col) * 16 + 8 * hh) * 2);
            acc = __builtin_amdgcn_mfma_f32_32x32x16_bf16(af, bfv, acc, 0, 0, 0);
        }
#pragma unroll
        for (int tp = 0; tp < 2; ++tp) {
            const unsigned a0_ = pk2(acc[8 * tp], acc[8 * tp + 1]), a1_ = pk2(acc[8 * tp + 2], acc[8 * tp + 3]);
            const unsigned b0_ = pk2(acc[8 * tp + 4], acc[8 * tp + 5]), b1_ = pk2(acc[8 * tp + 6], acc[8 * tp + 7]);
            const auto s0 = __builtin_amdgcn_permlane32_swap(a0_, b0_, false, false), s1 = __builtin_amdgcn_permlane32_swap(a1_, b1_, false, false);
            u32x4 o; o.x = s0[0]; o.y = s1[0]; o.z = s0[1]; o.w = s1[1];
            const int t = 64 * col + 2 * i + tp;
            *(u32x4*)(w.yssm + (size_t)(b * SEQ + t) * SSMW + g * GC + 8 * hh) = o;
        }
    }
    __syncthreads();
}


constexpr int B2_GP = 784;
constexpr int B2_LDS_G = 0, B2_LDS_R1 = 64 * B2_GP, B2_LDS_R2 = B2_LDS_R1 + 64 * 4 * 4, B2_LDS_Y = B2_LDS_R2 + 64 * 8 * 4;
__device__ __forceinline__ void b2_combine8(float* o, const bf16_t* __restrict__ dilO, size_t row, int c, float w0, float w1, float w2) {
    const u32x4 a = *(const u32x4*)(dilO + row * DILW + c), b = *(const u32x4*)(dilO + ((size_t)T + row) * DILW + c), d = *(const u32x4*)(dilO + ((size_t)2 * T + row) * DILW + c);
    o[0] = w0 * lo_bf(a.x) + w1 * lo_bf(b.x) + w2 * lo_bf(d.x); o[1] = w0 * hi_bf(a.x) + w1 * hi_bf(b.x) + w2 * hi_bf(d.x);
    o[2] = w0 * lo_bf(a.y) + w1 * lo_bf(b.y) + w2 * lo_bf(d.y); o[3] = w0 * hi_bf(a.y) + w1 * hi_bf(b.y) + w2 * hi_bf(d.y);
    o[4] = w0 * lo_bf(a.z) + w1 * lo_bf(b.z) + w2 * lo_bf(d.z); o[5] = w0 * hi_bf(a.z) + w1 * hi_bf(b.z) + w2 * hi_bf(d.z);
    o[6] = w0 * lo_bf(a.w) + w1 * lo_bf(b.w) + w2 * lo_bf(d.w); o[7] = w0 * hi_bf(a.w) + w1 * hi_bf(b.w) + w2 * hi_bf(d.w);
}
__device__ __forceinline__ void b2_fast_unit(LAS unsigned char* lds, const WS& w, int layer, const float* __restrict__ ssm_g, const float* __restrict__ dil_g, int tok0, int tid) {
    const int lane = tid & 63, wv = __builtin_amdgcn_readfirstlane(tid >> 6), col = lane & 31, hh = lane >> 5;
    { const int tk = tid >> 3, pc = (tid & 7) * 8;
#pragma unroll
      for (int i = 0; i < 6; ++i) {
          const u32x4 v = *(const u32x4*)(w.yssm + (size_t)(tok0 + tk) * SSMW + pc + 64 * i);
          u32x4 o; o.x = pk2(gelu_fast(lo_bf(v.x)), gelu_fast(hi_bf(v.x))); o.y = pk2(gelu_fast(lo_bf(v.y)), gelu_fast(hi_bf(v.y)));
          o.z = pk2(gelu_fast(lo_bf(v.z)), gelu_fast(hi_bf(v.z))); o.w = pk2(gelu_fast(lo_bf(v.w)), gelu_fast(hi_bf(v.w)));
          *(LAS u32x4*)(lds + B2_LDS_G + tk * B2_GP + (pc + 64 * i) * 2) = o;
      } }
    __builtin_amdgcn_sched_barrier(0);
    u32x4 dq0, dq1, dq2, dq3, dq4, dq5;
    const unsigned char* dO0 = (const unsigned char*)w.dilO; const unsigned char* dO1 = dO0 + (size_t)T * DILW * 2; const unsigned char* dO2 = dO1 + (size_t)T * DILW * 2;
    const unsigned char* dL0 = (const unsigned char*)w.dilL; const unsigned char* dL1 = dL0 + (size_t)T * DILH * 4; const unsigned char* dL2 = dL1 + (size_t)T * DILH * 4;
#define B2_DLOAD(it, PA, PB, PD, L0, L1, L2) { const int q_ = 512 * (it) + tid, tk_ = q_ / 48, hd_ = (q_ >> 3) % 6; \
        const unsigned offo_ = (unsigned)((tok0 + tk_) * DILW + 8 * (q_ - 48 * tk_)) * 2u, offl_ = (unsigned)((tok0 + tk_) * DILH + hd_) * 4u; \
        L0 = *(const float*)(dL0 + offl_); L1 = *(const float*)(dL1 + offl_); L2 = *(const float*)(dL2 + offl_); \
        PA = *(const u32x4*)(dO0 + offo_); PB = *(const u32x4*)(dO1 + offo_); PD = *(const u32x4*)(dO2 + offo_); }
#define B2_DCOMB(it, DQ, PA, PB, PD, L0, L1, L2) { const int q_ = 512 * (it) + tid, tk_ = q_ / 48, hd_ = (q_ >> 3) % 6; \
        const float mx_ = fmaxf(L0, fmaxf(L1, L2)); float w0 = __expf(L0 - mx_), w1 = __expf(L1 - mx_), w2 = __expf(L2 - mx_); \
        const float inv_ = 1.0f / (w0 + w1 + w2); w0 *= inv_; w1 *= inv_; w2 *= inv_; float o[8]; \
        o[0] = w0 * lo_bf(PA.x) + w1 * lo_bf(PB.x) + w2 * lo_bf(PD.x); o[1] = w0 * hi_bf(PA.x) + w1 * hi_bf(PB.x) + w2 * hi_bf(PD.x); \
        o[2] = w0 * lo_bf(PA.y) + w1 * lo_bf(PB.y) + w2 * lo_bf(PD.y); o[3] = w0 * hi_bf(PA.y) + w1 * hi_bf(PB.y) + w2 * hi_bf(PD.y); \
        o[4] = w0 * lo_bf(PA.z) + w1 * lo_bf(PB.z) + w2 * lo_bf(PD.z); o[5] = w0 * hi_bf(PA.z) + w1 * hi_bf(PB.z) + w2 * hi_bf(PD.z); \
        o[6] = w0 * lo_bf(PA.w) + w1 * lo_bf(PB.w) + w2 * lo_bf(PD.w); o[7] = w0 * hi_bf(PA.w) + w1 * hi_bf(PB.w) + w2 * hi_bf(PD.w); \
        float ss_ = ((o[0] * o[0] + o[1] * o[1]) + (o[2] * o[2] + o[3] * o[3])) + ((o[4] * o[4] + o[5] * o[5]) + (o[6] * o[6] + o[7] * o[7])); \
        DQ.x = pk2(o[0], o[1]); DQ.y = pk2(o[2], o[3]); DQ.z = pk2(o[4], o[5]); DQ.w = pk2(o[6], o[7]); \
        ss_ += dppmov<DPP_XOR1>(ss_); ss_ += dppmov<DPP_XOR2>(ss_); ss_ += __shfl_xor(ss_, 4); \
        if ((tid & 7) == 0) ((LAS float*)(lds + B2_LDS_R2))[tk_ * 8 + hd_] = ss_; }
    {
        u32x4 pa0, pb0, pd0, pa1, pb1, pd1; float la0, lb0, lc0, la1, lb1, lc1;
        B2_DLOAD(0, pa0, pb0, pd0, la0, lb0, lc0) B2_DLOAD(1, pa1, pb1, pd1, la1, lb1, lc1)
        B2_DCOMB(0, dq0, pa0, pb0, pd0, la0, lb0, lc0) B2_DCOMB(1, dq1, pa1, pb1, pd1, la1, lb1, lc1)
        __builtin_amdgcn_sched_barrier(0);
        B2_DLOAD(2, pa0, pb0, pd0, la0, lb0, lc0) B2_DLOAD(3, pa1, pb1, pd1, la1, lb1, lc1)
        B2_DCOMB(2, dq2, pa0, pb0, pd0, la0, lb0, lc0) B2_DCOMB(3, dq3, pa1, pb1, pd1, la1, lb1, lc1)
        __builtin_amdgcn_sched_barrier(0);
        B2_DLOAD(4, pa0, pb0, pd0, la0, lb0, lc0) B2_DLOAD(5, pa1, pb1, pd1, la1, lb1, lc1)
        B2_DCOMB(4, dq4, pa0, pb0, pd0, la0, lb0, lc0) B2_DCOMB(5, dq5, pa1, pb1, pd1, la1, lb1, lc1)
    }
#undef B2_DLOAD
#undef B2_DCOMB
    __syncthreads();
    const int tt = wv & 1, cg = wv >> 1;
    f32x16 acc[3];
#pragma unroll
    for (int nt = 0; nt < 3; ++nt)
#pragma unroll
        for (int r = 0; r < 16; ++r) acc[nt][r] = 0.f;
    const bf16_t* wg = w.WgluT + ((size_t)layer * SSMW * SSMW) + ((size_t)(cg * 3) * 24 * 64 + lane) * 8;
    const LAS unsigned char* gb = lds + B2_LDS_G + (32 * tt + col) * B2_GP + 16 * hh;
    bf16x8 af[2][12];
#define B2_LOADW(buf, ch) { _Pragma("unroll") for (int k4 = 0; k4 < 4; ++k4) _Pragma("unroll") for (int nt = 0; nt < 3; ++nt) af[buf][k4 * 3 + nt] = *(const bf16x8*)(wg + (size_t)(nt * 24 + 4 * (ch) + k4) * 512); }
    B2_LOADW(0, 0)
#pragma unroll
    for (int ch = 0; ch < 6; ++ch) {
        if (ch + 1 < 6) B2_LOADW((ch + 1) & 1, ch + 1)
        __builtin_amdgcn_sched_barrier(0);
#pragma unroll
        for (int k4 = 0; k4 < 4; ++k4) {
            const bf16x8 bfv = *(const LAS bf16x8*)(gb + 32 * (4 * ch + k4));
#pragma unroll
            for (int nt = 0; nt < 3; ++nt) acc[nt] = __builtin_amdgcn_mfma_f32_32x32x16_bf16(af[ch & 1][k4 * 3 + nt], bfv, acc[nt], 0, 0, 0);
        }
        __builtin_amdgcn_sched_barrier(0);
    }
#undef B2_LOADW
    float ss = 0.f;
#pragma unroll
    for (int nt = 0; nt < 3; ++nt)
#pragma unroll
        for (int g4 = 0; g4 < 4; ++g4) {
            const int n0 = 96 * cg + 32 * nt + 8 * g4 + 4 * hh;
            const u32x2 gv = *(const LAS u32x2*)(lds + B2_LDS_G + (32 * tt + col) * B2_GP + n0 * 2);
            const float g0 = lo_bf(gv.x), g1 = hi_bf(gv.x), g2 = lo_bf(gv.y), g3 = hi_bf(gv.y);
            const float y0 = g0 * __builtin_amdgcn_rcpf(1.0f + __builtin_amdgcn_exp2f(-1.4426950408889634f * acc[nt][4 * g4])), y1 = g1 * __builtin_amdgcn_rcpf(1.0f + __builtin_amdgcn_exp2f(-1.4426950408889634f * acc[nt][4 * g4 + 1]));
            const float y2 = g2 * __builtin_amdgcn_rcpf(1.0f + __builtin_amdgcn_exp2f(-1.4426950408889634f * acc[nt][4 * g4 + 2])), y3 = g3 * __builtin_amdgcn_rcpf(1.0f + __builtin_amdgcn_exp2f(-1.4426950408889634f * acc[nt][4 * g4 + 3]));
            ss += (y0 * y0 + y1 * y1) + (y2 * y2 + y3 * y3);
            u32x2 yo; yo.x = pk2(y0, y1); yo.y = pk2(y2, y3);
            *(LAS u32x2*)(lds + B2_LDS_Y + (32 * tt + col) * B2_GP + n0 * 2) = yo;
        }
    ss += __shfl_xor(ss, 32);
    if (hh == 0) ((LAS float*)(lds + B2_LDS_R1))[(32 * tt + col) * 4 + cg] = ss;
    __syncthreads();
    {
        const int tk = tid >> 3, pc = (tid & 7) * 8;
        const LAS float* r1 = (const LAS float*)(lds + B2_LDS_R1) + tk * 4;
        const float rn = rsqrtf(((r1[0] + r1[1]) + (r1[2] + r1[3])) * (1.0f / SSMW) + EPS);
        bf16_t* cr = w.cat + (size_t)(tok0 + tk) * DM + pc;
        f32x4 sgv[12];
#pragma unroll
        for (int i = 0; i < 6; ++i) { sgv[2 * i] = *(const f32x4*)(ssm_g + layer * SSMW + pc + 64 * i); sgv[2 * i + 1] = *(const f32x4*)(ssm_g + layer * SSMW + pc + 64 * i + 4); }
        __builtin_amdgcn_sched_barrier(0);
#pragma unroll
        for (int i = 0; i < 6; ++i) {
            const u32x4 yv = *(const LAS u32x4*)(lds + B2_LDS_Y + tk * B2_GP + (pc + 64 * i) * 2);
            const f32x4 ga = sgv[2 * i] * rn, gb2 = sgv[2 * i + 1] * rn;
            u32x4 o; o.x = pk2(lo_bf(yv.x) * ga[0], hi_bf(yv.x) * ga[1]); o.y = pk2(lo_bf(yv.y) * ga[2], hi_bf(yv.y) * ga[3]);
            o.z = pk2(lo_bf(yv.z) * gb2[0], hi_bf(yv.z) * gb2[1]); o.w = pk2(lo_bf(yv.w) * gb2[2], hi_bf(yv.w) * gb2[3]);
            *(u32x4*)(cr + 64 * i) = o;
        }
    }
    int tid3 = tid; asm volatile("" : "+v"(tid3));
#define B2_DSTORE(it, DQ) { const int q_ = 512 * (it) + tid3, tk_ = q_ / 48, c_ = 8 * (q_ - 48 * tk_); \
        const f32x4 ga_ = *(const f32x4*)((const unsigned char*)(dil_g + layer * DILW) + (unsigned)c_ * 4u), gb_ = *(const f32x4*)((const unsigned char*)(dil_g + layer * DILW) + (unsigned)c_ * 4u + 16u); \
        const LAS float* r2_ = (const LAS float*)(lds + B2_LDS_R2) + tk_ * 8; \
        const float rn_ = rsqrtf((((r2_[0] + r2_[1]) + (r2_[2] + r2_[3])) + (r2_[4] + r2_[5])) * (1.0f / DILW) + EPS); \
        u32x4 qo_; qo_.x = pk2(lo_bf(DQ.x) * rn_ * ga_[0], hi_bf(DQ.x) * rn_ * ga_[1]); qo_.y = pk2(lo_bf(DQ.y) * rn_ * ga_[2], hi_bf(DQ.y) * rn_ * ga_[3]); \
        qo_.z = pk2(lo_bf(DQ.z) * rn_ * gb_[0], hi_bf(DQ.z) * rn_ * gb_[1]); qo_.w = pk2(lo_bf(DQ.w) * rn_ * gb_[2], hi_bf(DQ.w) * rn_ * gb_[3]); \
        *(u32x4*)((unsigned char*)w.cat + (unsigned)((tok0 + tk_) * DM + SSMW + c_) * 2u) = qo_; }
    B2_DSTORE(0, dq0) B2_DSTORE(1, dq1) B2_DSTORE(2, dq2) B2_DSTORE(3, dq3) B2_DSTORE(4, dq4) B2_DSTORE(5, dq5)
#undef B2_DSTORE
    __syncthreads();
}

namespace pg8 {
#define PG8_LAS __attribute__((address_space(3)))
typedef unsigned short bf16_t;
typedef short bf16x8 __attribute__((ext_vector_type(8)));
typedef float f32x4 __attribute__((ext_vector_type(4)));
typedef unsigned u32x4 __attribute__((ext_vector_type(4)));
constexpr int BM = 256, BK = 64, HALF = 128, HTB = HALF * BK * 2  , STAGE_BYTES = 8 * HTB, NXCD = 8, WGM = 8;

__host__ __device__ __forceinline__ int lds_byte(int r, int c) { const int st = (r >> 4) * 2 + (c >> 5), rr = r & 15, cc = c & 31, ob = rr * 64 + cc * 2; return st * 1024 + (ob ^ (((ob >> 9) & 1) << 5)); }
__host__ __device__ __forceinline__ void stage_rc(int b, int& R, int& C) { const int st = b / 1024, sb = b % 1024, swz = sb ^ (((sb >> 9) & 1) << 5); R = (st >> 1) * 16 + swz / 64; C = (st & 1) * 32 + (swz % 64) / 2; }
__host__ __device__ __forceinline__ int perm32(int rho) { const int n = rho >> 4, i = rho & 15; return 8 * (i >> 2) + 4 * n + (i & 3); }

struct Unit { int pm, pn; };
struct Gemm { const bf16_t* A; const bf16_t* Bt; int M, N, K; };

struct StaticOrder {
    int nM, nN, nwg, G, c;
    __host__ __device__ void init(int M, int N, int G_, int c_) { nM = M / BM; nN = N / BM; nwg = nM * nN; G = G_; c = c_; }
    __host__ __device__ bool next(int i, Unit& u) const {
        const long L = (long)i * G + c; if (L >= nwg) return false;
        int wgid = (int)L; { const int q = nwg / NXCD, r = nwg % NXCD, xcd = wgid % NXCD, off = wgid / NXCD; wgid = (xcd < r ? xcd * (q + 1) : r * (q + 1) + (xcd - r) * q) + off; }
        const int nig = WGM * nN, gid = wgid / nig, fm = gid * WGM, gsz = (nM - fm) < WGM ? (nM - fm) : WGM;
        u.pm = fm + ((wgid % nig) % gsz); u.pn = (wgid % nig) / gsz; return true;
    }
    __device__ __forceinline__ void a_ready(const Unit&) const {}
    __device__ __forceinline__ void done(const Unit&) const {}
};
struct SkipOrder {
    StaticOrder so; int skip;
    __device__ __forceinline__ bool next(int i, Unit& u) const { if (!so.next(i, u)) return false; u.pn += (u.pn >= skip) ? 1 : 0; return true; }
    __device__ __forceinline__ void a_ready(const Unit&) const {}
    __device__ __forceinline__ void done(const Unit&) const {}
};
struct OneUnit {
    int pm, pn;
    __device__ __forceinline__ bool next(int i, Unit& u) const { if (i) return false; u.pm = pm; u.pn = pn; return true; }
    __device__ __forceinline__ void a_ready(const Unit&) const {}
    __device__ __forceinline__ void done(const Unit&) const {}
};


__device__ __forceinline__ unsigned pk2bf(float a, float b) {
    typedef __bf16 bf2 __attribute__((ext_vector_type(2))); typedef float f2 __attribute__((ext_vector_type(2)));
    f2 v = {a, b}; bf2 r = __builtin_convertvector(v, bf2); return __builtin_bit_cast(unsigned, r);
}
struct EpiScaleBf16 {
    static constexpr bool PERM = true, AFTER_DRAIN = false;
    bf16_t* O; int ldc; const float* rs; const float* ssqp;
    __device__ __forceinline__ void operator()(const f32x4 (&acc)[2][2][4][2], const Unit& u, int wr, int wc, int fr, int fq) const {
        const int row0 = u.pm * BM + wr * 64 + fr, col0 = u.pn * BM + wc * 32 + 8 * fq;
        float sc8[8];
        if (ssqp) {
            f32x4 pq[8];
#pragma unroll
            for (int it = 0; it < 8; ++it) pq[it] = *(const f32x4*)(ssqp + (size_t)(row0 + (it >> 2) * HALF + (it & 3) * 16) * 16 + 4 * fq);
#pragma unroll
            for (int it = 0; it < 8; ++it) { float t = (pq[it][0] + pq[it][1]) + (pq[it][2] + pq[it][3]); t += __shfl_xor(t, 16); t += __shfl_xor(t, 32); sc8[it] = __builtin_amdgcn_rsqf(t * (1.0f / 1024.0f) + 1e-6f); }
        } else {
#pragma unroll
            for (int it = 0; it < 8; ++it) sc8[it] = rs[row0 + (it >> 2) * HALF + (it & 3) * 16];
        }
        __builtin_amdgcn_sched_barrier(0);
#pragma unroll
        for (int ai = 0; ai < 2; ++ai)
#pragma unroll
            for (int m = 0; m < 4; ++m) {
                const int row = row0 + ai * HALF + m * 16;
                const float sc = sc8[ai * 4 + m];
                bf16_t* rowp = O + (size_t)row * ldc + col0;
#pragma unroll
                for (int bj = 0; bj < 2; ++bj) {
                    const f32x4 v0 = acc[ai][bj][m][0] * sc, v1 = acc[ai][bj][m][1] * sc;
                    u32x4 w; w.x = pk2bf(v0[0], v0[1]); w.y = pk2bf(v0[2], v0[3]); w.z = pk2bf(v1[0], v1[1]); w.w = pk2bf(v1[2], v1[3]);
                    *(u32x4*)(rowp + bj * HALF) = w;
                }
            }
    }
};
struct EpiScaleQ {
    static constexpr bool PERM = true, AFTER_DRAIN = false;
    bf16_t* O; const float* ssqp;
    __device__ __forceinline__ void operator()(const f32x4 (&acc)[2][2][4][2], const Unit& u, int wr, int wc, int fr, int fq) const {
        const int row0 = u.pm * BM + wr * 64 + fr;
        float sc8[8];
        { f32x4 pq[8];
#pragma unroll
          for (int it = 0; it < 8; ++it) pq[it] = *(const f32x4*)(ssqp + (size_t)(row0 + (it >> 2) * HALF + (it & 3) * 16) * 16 + 4 * fq);
#pragma unroll
          for (int it = 0; it < 8; ++it) { float t = (pq[it][0] + pq[it][1]) + (pq[it][2] + pq[it][3]); t += __shfl_xor(t, 16); t += __shfl_xor(t, 32); sc8[it] = __builtin_amdgcn_rsqf(t * (1.0f / 1024.0f) + 1e-6f); } }
        __builtin_amdgcn_sched_barrier(0);
        const int ks = 2 * wc + (fq >> 1), hq = fq & 1;
#pragma unroll
        for (int ai = 0; ai < 2; ++ai)
#pragma unroll
            for (int m = 0; m < 4; ++m) {
                const int row = row0 + ai * HALF + m * 16;
                const float sc = sc8[ai * 4 + m];
                const int tb = row >> 5, tl = row & 31;
#pragma unroll
                for (int bj = 0; bj < 2; ++bj) {
                    const f32x4 v0 = acc[ai][bj][m][0] * sc, v1 = acc[ai][bj][m][1] * sc;
                    u32x4 w; w.x = pk2bf(v0[0], v0[1]); w.y = pk2bf(v0[2], v0[3]); w.z = pk2bf(v1[0], v1[1]); w.w = pk2bf(v1[2], v1[3]);
                    *(u32x4*)(O + ((size_t)((((tb * 8 + u.pn) * 2 + bj) * 8 + ks) * 64 + tl + 32 * hq)) * 8) = w;
                }
            }
    }
};
struct EpiResid {
    static constexpr bool PERM = true, AFTER_DRAIN = false;
    const bf16_t* XI; bf16_t* XB; float* ssqp;
    __device__ __forceinline__ void operator()(const f32x4 (&acc)[2][2][4][2], const Unit& u, int wr, int wc, int fr, int fq) const {
        const int row0 = u.pm * BM + wr * 64 + fr, col0 = u.pn * BM + wc * 32 + 8 * fq;
        constexpr int NPF = 5;
        u32x4 xr[NPF + 1][2];
#define ER_LOAD(slot, it) { const bf16_t* pi_ = XI + (size_t)(row0 + ((it) >> 2) * HALF + ((it) & 3) * 16) * 1024 + col0; xr[slot][0] = *(const u32x4*)pi_; xr[slot][1] = *(const u32x4*)(pi_ + HALF); }
#pragma unroll
        for (int it = 0; it < NPF; ++it) ER_LOAD(it, it)
#pragma unroll
        for (int it = 0; it < 8; ++it) {
            if (it + NPF < 8) ER_LOAD((it + NPF) % (NPF + 1), it + NPF)
            const int ai = it >> 2, m = it & 3, row = row0 + ai * HALF + m * 16;
            float ss = 0.f;
#pragma unroll
            for (int bj = 0; bj < 2; ++bj) {
                const u32x4 xv = xr[it % (NPF + 1)][bj];
                const f32x4 xa = {lo_bf(xv.x), hi_bf(xv.x), lo_bf(xv.y), hi_bf(xv.y)}, xc = {lo_bf(xv.z), hi_bf(xv.z), lo_bf(xv.w), hi_bf(xv.w)};
                const f32x4 a = xa + acc[ai][bj][m][0], b = xc + acc[ai][bj][m][1];
                ss += (a[0] * a[0] + a[1] * a[1]) + (a[2] * a[2] + a[3] * a[3]) + (b[0] * b[0] + b[1] * b[1]) + (b[2] * b[2] + b[3] * b[3]);
                u32x4 w; w.x = pk2bf(a[0], a[1]); w.y = pk2bf(a[2], a[3]); w.z = pk2bf(b[0], b[1]); w.w = pk2bf(b[2], b[3]);
                *(u32x4*)(XB + (size_t)row * 1024 + col0 + bj * HALF) = w;
            }
            ss += __shfl_xor(ss, 16); ss += __shfl_xor(ss, 32);
            if (fq == 0) ssqp[(size_t)row * 16 + u.pn * 4 + wc] = ss;
        }
#undef ER_LOAD
    }
};

template <class Epi, class Sched, bool ALIGN_EPI = false, bool SP2 = false>
__device__ __forceinline__ void gemm_phase(PG8_LAS unsigned char* lds, const Gemm g, const Sched& S, const Epi& E, const int tid) {
    const int wid = __builtin_amdgcn_readfirstlane(tid >> 6), lane = tid & 63, wr = wid >> 2, wc = wid & 3, fr = lane & 15, fq = lane >> 4;
    const int K = g.K, nt = K / BK;
    unsigned voffA[2], voffB[2];
#pragma unroll
    for (int i = 0; i < 2; ++i) { int R, C; stage_rc(tid * 16 + i * 8192, R, C); const int Rb = Epi::PERM ? ((R & ~31) + perm32(R & 31)) : R;
        voffA[i] = (unsigned)(R * K + C) * 2u; voffB[i] = (unsigned)(Rb * K + C) * 2u; }
    const size_t kstep = (size_t)(BK * 2);
    const size_t hstep = (size_t)HALF * K * 2;
    const size_t tstep = 2 * hstep;
    const unsigned ldsw = (unsigned)wid * 1024u;
    const int aoff = lds_byte(wr * 64 + fr, fq * 8), boff = lds_byte(wc * 32 + fr, fq * 8);
#define PG8_SA(b, h) (((b) * 2 + (h)) * HTB)
#define PG8_SB(b, h) ((4 + (b) * 2 + (h)) * HTB)
#define PG8_STAGE(bufoff, gbase, voff) do { _Pragma("unroll") for (int _i = 0; _i < 2; ++_i) \
        __builtin_amdgcn_global_load_lds((const unsigned*)((const char*)(gbase) + (voff)[_i]), (PG8_LAS unsigned*)(lds + (bufoff) + ldsw + _i * 8192), 16, 0, 0); } while (0)
#define PG8_LDA(dst, b, h) do { _Pragma("unroll") for (int m = 0; m < 4; ++m) _Pragma("unroll") for (int k = 0; k < 2; ++k) dst[m][k] = *(const PG8_LAS bf16x8*)(lds + PG8_SA(b, h) + aoff + m * 2048 + k * 1024); } while (0)
#define PG8_LDB(dst, b, h) do { _Pragma("unroll") for (int n = 0; n < 2; ++n) _Pragma("unroll") for (int k = 0; k < 2; ++k) dst[n][k] = *(const PG8_LAS bf16x8*)(lds + PG8_SB(b, h) + boff + n * 2048 + k * 1024); } while (0)
#define PG8_MMA(ai, bj, At, Bt) do { __builtin_amdgcn_s_setprio(1); _Pragma("unroll") for (int m = 0; m < 4; ++m) _Pragma("unroll") for (int n = 0; n < 2; ++n) _Pragma("unroll") for (int k = 0; k < 2; ++k) \
        acc[ai][bj][m][n] = __builtin_amdgcn_mfma_f32_16x16x32_bf16(Bt[n][k], At[m][k], acc[ai][bj][m][n], 0, 0, 0); __builtin_amdgcn_s_setprio(0); } while (0)
#define PG8_WAIT_V(n) asm volatile("s_waitcnt vmcnt(" #n ")" ::: "memory")
#define PG8_WAIT_L(n) asm volatile("s_waitcnt lgkmcnt(" #n ")" ::: "memory")
#define PG8_BAR __builtin_amdgcn_s_barrier()
#define PG8_SCHED __builtin_amdgcn_sched_barrier(0)
    Unit cur, nxt; int ui = 0;
    if (!S.next(0, cur)) return;
    f32x4 acc[2][2][4][2];
#pragma unroll
    for (int a = 0; a < 2; ++a)
#pragma unroll
        for (int b = 0; b < 2; ++b)
#pragma unroll
            for (int m = 0; m < 4; ++m)
#pragma unroll
                for (int n = 0; n < 2; ++n) acc[a][b][m][n] = (f32x4){0.f, 0.f, 0.f, 0.f};
    bf16x8 At[4][2], B0[2][2], B1[2][2];
    const char* cA = (const char*)g.A + (size_t)cur.pm * tstep; const char* cB = (const char*)g.Bt + (size_t)cur.pn * tstep;
    S.a_ready(cur);
    if constexpr (SP2) {
        PG8_STAGE(PG8_SB(0, 0), cB, voffB); PG8_STAGE(PG8_SB(0, 1), cB + hstep, voffB); PG8_STAGE(PG8_SA(0, 0), cA, voffA); PG8_STAGE(PG8_SA(0, 1), cA + hstep, voffA);
        if (wr == 1) PG8_BAR;
        PG8_WAIT_V(2); PG8_BAR;
        PG8_STAGE(PG8_SB(1, 0), cB + kstep, voffB); PG8_STAGE(PG8_SA(1, 0), cA + kstep, voffA); PG8_STAGE(PG8_SB(1, 1), cB + hstep + kstep, voffB);
        PG8_WAIT_V(6); PG8_BAR;
    } else {
        PG8_STAGE(PG8_SB(0, 0), cB, voffB); PG8_STAGE(PG8_SA(0, 0), cA, voffA); PG8_STAGE(PG8_SB(0, 1), cB + hstep, voffB); PG8_STAGE(PG8_SA(0, 1), cA + hstep, voffA);
        if (wr == 1) PG8_BAR;
        PG8_WAIT_V(4); PG8_BAR;
        PG8_STAGE(PG8_SB(1, 0), cB + kstep, voffB); PG8_STAGE(PG8_SA(1, 0), cA + kstep, voffA); PG8_STAGE(PG8_SB(1, 1), cB + hstep + kstep, voffB);
        PG8_WAIT_V(6); PG8_BAR;
    }
    for (;;) {
        const bool has_next = S.next(ui + 1, nxt);
        const char* nA = has_next ? (const char*)g.A + (size_t)nxt.pm * tstep : cA; const char* nB = has_next ? (const char*)g.Bt + (size_t)nxt.pn * tstep : cB;
        for (int t = 0; t < nt; t += 2) {
            const bool last = (t == nt - 2);
            const char* a1 = cA + (size_t)(t + 1) * kstep;
            const char* a2 = last ? nA : cA + (size_t)(t + 2) * kstep; const char* b2 = last ? nB : cB + (size_t)(t + 2) * kstep;
            const char* a3 = a2 + kstep; const char* b3 = b2 + kstep;
            if (last && has_next) S.a_ready(nxt);
            if constexpr (SP2) {
            PG8_LDB(B0, 0, 0); PG8_LDB(B1, 0, 1); PG8_SCHED; PG8_LDA(At, 0, 0); PG8_STAGE(PG8_SA(1, 1), a1 + hstep, voffA);
            PG8_WAIT_V(8); PG8_WAIT_L(0); PG8_BAR; PG8_MMA(0, 0, At, B0); PG8_MMA(0, 1, At, B1); PG8_BAR; PG8_SCHED;
            PG8_LDA(At, 0, 1); PG8_STAGE(PG8_SB(0, 0), b2, voffB); PG8_STAGE(PG8_SB(0, 1), b2 + hstep, voffB); PG8_STAGE(PG8_SA(0, 0), a2, voffA);
            PG8_WAIT_V(8); PG8_WAIT_L(0); PG8_BAR; PG8_MMA(1, 0, At, B0); PG8_MMA(1, 1, At, B1); PG8_BAR; PG8_SCHED;
            PG8_LDB(B0, 1, 0); PG8_LDB(B1, 1, 1); PG8_SCHED; PG8_LDA(At, 1, 0); PG8_STAGE(PG8_SA(0, 1), a2 + hstep, voffA);
            PG8_WAIT_V(8); PG8_WAIT_L(0); PG8_BAR; PG8_MMA(0, 0, At, B0); PG8_MMA(0, 1, At, B1); PG8_BAR; PG8_SCHED;
            PG8_LDA(At, 1, 1); PG8_STAGE(PG8_SB(1, 0), b3, voffB); PG8_STAGE(PG8_SB(1, 1), b3 + hstep, voffB); PG8_STAGE(PG8_SA(1, 0), a3, voffA);
            PG8_WAIT_V(8); PG8_WAIT_L(0); PG8_BAR; PG8_MMA(1, 0, At, B0); PG8_MMA(1, 1, At, B1); PG8_BAR; PG8_SCHED;
            } else {
            PG8_LDB(B0, 0, 0); PG8_SCHED; PG8_LDA(At, 0, 0); PG8_STAGE(PG8_SA(1, 1), a1 + hstep, voffA);
            PG8_WAIT_L(8); PG8_BAR; PG8_WAIT_L(0); PG8_MMA(0, 0, At, B0); PG8_BAR; PG8_SCHED;
            PG8_LDB(B1, 0, 1); PG8_STAGE(PG8_SB(0, 0), b2, voffB);
            PG8_BAR; PG8_WAIT_L(0); PG8_MMA(0, 1, At, B1); PG8_BAR;
            PG8_LDA(At, 0, 1); PG8_STAGE(PG8_SA(0, 0), a2, voffA);
            PG8_BAR; PG8_WAIT_L(0); PG8_MMA(1, 0, At, B0); PG8_BAR; PG8_SCHED;
            PG8_STAGE(PG8_SB(0, 1), b2 + hstep, voffB);
            PG8_WAIT_V(6); PG8_BAR; PG8_MMA(1, 1, At, B1); PG8_BAR;
            PG8_LDB(B0, 1, 0); PG8_SCHED; PG8_LDA(At, 1, 0); PG8_STAGE(PG8_SA(0, 1), a2 + hstep, voffA);
            PG8_WAIT_L(8); PG8_BAR; PG8_WAIT_L(0); PG8_MMA(0, 0, At, B0); PG8_BAR; PG8_SCHED;
            PG8_LDB(B1, 1, 1); PG8_STAGE(PG8_SB(1, 0), b3, voffB);
            PG8_BAR; PG8_WAIT_L(0); PG8_MMA(0, 1, At, B1); PG8_BAR;
            PG8_LDA(At, 1, 1); PG8_STAGE(PG8_SA(1, 0), a3, voffA);
            PG8_BAR; PG8_WAIT_L(0); PG8_MMA(1, 0, At, B0); PG8_BAR; PG8_SCHED;
            PG8_STAGE(PG8_SB(1, 1), b3 + hstep, voffB);
            PG8_WAIT_V(6); PG8_BAR; PG8_MMA(1, 1, At, B1); PG8_BAR;
            }
        }
        if constexpr (ALIGN_EPI) { if (wr == 0) PG8_BAR; }
        if constexpr (!Epi::AFTER_DRAIN) { E(acc, cur, wr, wc, fr, fq); S.done(cur); }
        if (!has_next) break;
#pragma unroll
        for (int a = 0; a < 2; ++a)
#pragma unroll
            for (int b = 0; b < 2; ++b)
#pragma unroll
                for (int m = 0; m < 4; ++m)
#pragma unroll
                    for (int n = 0; n < 2; ++n) acc[a][b][m][n] = (f32x4){0.f, 0.f, 0.f, 0.f};
        cur = nxt; cA = nA; cB = nB; ++ui;
        if constexpr (ALIGN_EPI) { if (wr == 1) PG8_BAR; }
    }
    PG8_WAIT_V(0);
    if constexpr (!ALIGN_EPI) { if (wr == 0) PG8_BAR; }
    PG8_BAR;
    if constexpr (Epi::AFTER_DRAIN) { E.fused(acc, cur, wr, wc, fr, fq, lds, wid, lane); S.done(cur); }
#undef PG8_SA
#undef PG8_SB
#undef PG8_STAGE
#undef PG8_LDA
#undef PG8_LDB
#undef PG8_MMA
#undef PG8_WAIT_V
#undef PG8_WAIT_L
#undef PG8_BAR
#undef PG8_SCHED
}
}

#define XB_TMO      128
#define XB_XCNT(j)  (256  + 64 * (j))
#define XB_XSUB(j)  (1280 + 64 * (j))
#define XB_XGEN(j)  (2304 + 64 * (j))
#define XB_TOP      3328
#define XB_TOPGEN   3392
#define XCD_BAR_WORDS 3456
#define XB_SPIN_CAP (1u << 22)

__device__ __forceinline__ unsigned xb_ld(unsigned* p)              { return __hip_atomic_load(p, __ATOMIC_RELAXED, __HIP_MEMORY_SCOPE_AGENT); }
__device__ __forceinline__ unsigned xb_add(unsigned* p, unsigned v) { return __hip_atomic_fetch_add(p, v, __ATOMIC_RELAXED, __HIP_MEMORY_SCOPE_AGENT); }
__device__ __forceinline__ unsigned xb_xcc_id() { return (unsigned)__builtin_amdgcn_s_getreg((3 << 11) | 20) & 0xFu; }
#define XB_SPIN(cond, bar) do { unsigned _sp = 0; while (cond) { __builtin_amdgcn_s_sleep(1); \
    if ((++_sp & 255u) == 0u) { if (xb_ld(&(bar)[XB_TMO])) break; if (_sp > XB_SPIN_CAP) { atomicAdd(&(bar)[XB_TMO], 1u); break; } } } } while (0)

struct XcdBarrier {
    unsigned* bar; unsigned x;
    volatile LAS unsigned* st;
};

__device__ __forceinline__ XcdBarrier xcd_barrier_post(unsigned* bar, volatile LAS unsigned* st) {
    XcdBarrier b; b.bar = bar; b.x = xb_xcc_id(); b.st = st;
    if (threadIdx.x == 0) (void)xb_add(&bar[XB_XCNT(b.x)], 1u);
    return b;
}
__device__ __forceinline__ void xcd_barrier_complete(unsigned* bar, unsigned x, unsigned& nloc, unsigned& nx) {
    const unsigned G = gridDim.x * gridDim.y * gridDim.z;
    unsigned sum, cnt, mine, sp = 0u;
    for (;;) {
        sum = 0u; cnt = 0u; mine = 0u;
#pragma unroll
        for (unsigned j = 0; j < 16; ++j) { const unsigned c = xb_ld(&bar[XB_XCNT(j)]); sum += c; cnt += (c > 0u) ? 1u : 0u; mine = (j == x) ? c : mine; }
        if (sum == G) break;
        __builtin_amdgcn_s_sleep(1);
        if ((++sp & 255u) == 0u) { if (xb_ld(&bar[XB_TMO])) break; if (sp > XB_SPIN_CAP) { atomicAdd(&bar[XB_TMO], 1u); break; } }
    }
    nloc = mine > 0u ? mine : 1u; nx = cnt > 0u ? cnt : 1u;
}

__device__ __forceinline__ void xcd_barrier(const XcdBarrier& b) {
    asm volatile("s_waitcnt vmcnt(0)" ::: "memory");
    __syncthreads();
    if (threadIdx.x == 0) {
        unsigned* bar = b.bar;
        __builtin_amdgcn_s_waitcnt(0);
        unsigned nloc = b.st[0], nx = b.st[1];
        if (nloc == 0u) { xcd_barrier_complete(bar, b.x, nloc, nx); b.st[0] = nloc; b.st[1] = nx; }
        const unsigned old = xb_add(&bar[XB_XSUB(b.x)], 1u);
        const unsigned gen = old / nloc;
        if (old + 1u == (gen + 1u) * nloc) {
            __builtin_amdgcn_fence(__ATOMIC_RELEASE, "agent");
            asm volatile("s_waitcnt vmcnt(0)" ::: "memory");
            const unsigned og = xb_add(&bar[XB_TOP], 1u);
            const unsigned tg = og / nx;
            if (og + 1u == (tg + 1u) * nx) xb_add(&bar[XB_TOPGEN], 1u);
            else XB_SPIN(xb_ld(&bar[XB_TOPGEN]) == tg, bar);
            __builtin_amdgcn_fence(__ATOMIC_ACQUIRE, "agent");
            xb_add(&bar[XB_XGEN(b.x)], 1u);
            asm volatile("s_waitcnt vmcnt(0)" ::: "memory");
        } else {
            XB_SPIN(xb_ld(&bar[XB_XGEN(b.x)]) == gen, bar);
            __builtin_amdgcn_fence(__ATOMIC_ACQUIRE, "agent");
            asm volatile("s_waitcnt vmcnt(0)" ::: "memory");
        }
    }
    __syncthreads();
}

#ifndef PROBE_K
#define PROBE_K (-1)
#endif
#ifndef PROBE_REP
#define PROBE_REP 3
#endif
namespace cg = cooperative_groups;
constexpr int NTHR = 512, NWAVE = 8;
constexpr int PH_PER_LAYER = 7;
constexpr int N_PRE = 1;
constexpr int N_PHASES = N_PRE + NL * PH_PER_LAYER;
constexpr int LDS_BYTES = 144 * 1024;

struct Args { const float* in[26]; float* out; unsigned char* ws; int ph_lo, ph_hi; };

__global__ void __launch_bounds__(NTHR, 2) mega(Args a) {
    extern __shared__ __attribute__((aligned(16))) unsigned char lds[];
    cg::grid_group grid = cg::this_grid();
    const int G = gridDim.x;
    XcdBarrier xbar;
    { volatile LAS unsigned* stw = (volatile LAS unsigned*)((LAS unsigned char*)lds + LDS_BYTES - 32);
      if (threadIdx.x < 4) stw[threadIdx.x] = 0u;
      __syncthreads();
      WS w0; ws_carve(a.ws, w0);
      xbar = xcd_barrier_post(w0.bar, stw); }
    const float* x = a.in[0]; const float* norm1_g = a.in[1]; const float* w_in = a.in[2];
    const float* lam_re = a.in[3]; const float* lam_im = a.in[4]; const float* log_step = a.in[5];
    const float* b_re = a.in[6]; const float* b_im = a.in[7]; const float* c_re = a.in[8]; const float* c_im = a.in[9];
    const float* ssm_d = a.in[10]; const float* w_glu = a.in[11]; const float* ssm_g = a.in[12]; const float* dil_g = a.in[13];
    const float* lq1 = a.in[14]; const float* lk1 = a.in[15]; const float* lq2 = a.in[16]; const float* lk2 = a.in[17];
    const float* subg = a.in[18]; const float* w_out = a.in[19]; const float* norm2_g = a.in[20];
    const float* w_query = a.in[21]; const float* sub_keys = a.in[22]; const float* peer_u = a.in[23]; const float* peer_v = a.in[24];
    const float* fin_g = a.in[25];

    for (int ph = a.ph_lo; ph < a.ph_hi; ++ph) {
        int reps = 1;
#if PROBE_K >= 0
        if (PROBE_K >= 100 ? (ph == PROBE_K - 100) : (ph >= N_PRE && (ph - N_PRE) % PH_PER_LAYER == (PROBE_K == 50 ? 0 : PROBE_K))) reps = PROBE_REP;
#endif
      for (int rep_i = 0; rep_i < reps; ++rep_i) {
        int tid = threadIdx.x, bid = blockIdx.x; size_t zoff = 0;
        asm volatile("" : "+v"(tid)); asm volatile("" : "+s"(bid)); asm volatile("" : "+s"(zoff));
        unsigned char* wsb = a.ws + zoff;
        WS w; ws_carve(wsb, w);
        S5Tab st; st.Ktab = w.s5k; st.Wend = w.s5we; st.Wout = w.s5wo; st.lam_re = lam_re; st.lam_im = lam_im; st.log_step = log_step;
        const int lane = tid & 63, wv = __builtin_amdgcn_readfirstlane(tid >> 6);
        const int gw = bid * NWAVE + wv, nw = G * NWAVE;
        const size_t gtid = (size_t)bid * NTHR + tid, gthreads = (size_t)G * NTHR;
        if (PROBE_K == 50 && rep_i > 0) {
        } else if (ph == 0) {
            float* tile = (float*)lds;
            constexpr int T_IN = (INW / 64) * (DM / 64), T_OUT = (DM / 64) * (DM / 64), T_Q = (2048 / 64) * (DM / 64);
            constexpr int T_L = T_IN + T_OUT + T_Q;
            const int GA = G >> 1, GB = G - GA;
            if (bid < GA) {
                for (int it = bid; it < NL * NG * 8; it += GA) s5_prep_task((LAS unsigned char*)lds, st, lam_re, lam_im, log_step, b_re, b_im, c_re, c_im, ssm_d, it >> 3, it & 7, tid);
                transpose_tiles(tile, bid, GA, NL * T_L, tid, w_in, norm1_g, w_out, w_query, norm2_g, w_glu, w);
                for (int f = (int)gtid; f < NL * 4 * 3 * 24 * 64; f += GA * NTHR) {
                    const int ln = f & 63, ks = (f >> 6) % 24, nt = (f / (64 * 24)) % 3, cgq = (f / (64 * 24 * 3)) & 3, l = f / (64 * 24 * 3 * 4);
                    const float* src = w_glu + (size_t)l * SSMW * SSMW + (size_t)(16 * ks + 8 * (ln >> 5)) * SSMW + 96 * cgq + 32 * nt + (ln & 31);
                    u32x4 o; o.x = pk2(src[0], src[SSMW]); o.y = pk2(src[2 * SSMW], src[3 * SSMW]); o.z = pk2(src[4 * SSMW], src[5 * SSMW]); o.w = pk2(src[6 * SSMW], src[7 * SSMW]);
                    *(u32x4*)(w.WgluT + (size_t)f * 8) = o;
                }
            }
            convert_body(sub_keys, nullptr, w.SKb, (size_t)NL * PH * 2 * PK * PHALF / 8, PHALF, 1, gtid, gthreads);
            constexpr int NPAIR = NL * PE / 2, VSPLIT = NPAIR * 5 / 8;
            if (bid >= GA) {
                const int gwb = (bid - GA) * NWAVE + wv, nwb = GB * NWAVE;
                convert_fp6_body(peer_u, norm2_g, w.U8, 0, NPAIR, PEER_USCALE, gwb, nwb, lane);
                convert_fp6_body(peer_v, nullptr, w.V8, 0, VSPLIT, PEER_VSCALE, gwb, nwb, lane);
            } else {
                convert_fp6_body(peer_v, nullptr, w.V8, VSPLIT, NPAIR, PEER_VSCALE, gw, GA * NWAVE, lane);
            }
            rowstat_rows(x, w.xb, w.rs1, gw, nw, lane);
        } else {
            const int l = (ph - N_PRE) / PH_PER_LAYER, k = (ph - N_PRE) % PH_PER_LAYER;
            if (k == 0) {
                pg8::Gemm g{w.xb, w.WinT + (size_t)l * INW * DM, T, INW, DM}; pg8::SkipOrder S; S.so.init(T, INW - 256, G, bid); S.skip = A_DEFER;
                pg8::EpiScaleBf16 E{w.proj, INW, w.rs1, nullptr};
                pg8::gemm_phase<pg8::EpiScaleBf16, pg8::SkipOrder, true, true>((LAS unsigned char*)lds, g, S, E, tid);
            } else if (k == 1) {
                AttnOut ao; ao.cat = w.cat; ao.dilO = w.dilO; ao.dilL = w.dilL; ao.subg = subg; ao.layer = l;
                { const int li = l * 32 + (lane & 31);
                  const float s1 = wave_sum((lane < 32) ? lq1[li] * lk1[li] : 0.f), s2 = wave_sum((lane < 32) ? lq2[li] * lk2[li] : 0.f);
                  ao.lam_init = 0.8f - 0.6f * expf(-0.3f * (float)l); ao.lam = expf(s1) - expf(s2) + ao.lam_init; }
                volatile LAS unsigned* uq = (volatile LAS unsigned*)(lds + LDS_BYTES - 16);
                bool dil_ready = false;
                for (;;) {
                    if (tid == 0) uq[0] = atomicAdd(&w.ctr[l * 8 + rep_i], 1u);
                    __syncthreads();
                    const unsigned u = uq[0];
                    __syncthreads();
                    if (u >= (unsigned)(N_ATTN_UNITS + NB * NG + T / 256)) break;
                    int tu = tid; asm volatile("" : "+v"(tu));
                    if (u < (unsigned)(T / 256)) {
                        pg8::Gemm g{w.xb, w.WinT + (size_t)l * INW * DM, T, INW, DM}; pg8::OneUnit S1{(int)u, A_DEFER};
                        pg8::EpiScaleBf16 E{w.proj, INW, w.rs1, nullptr};
                        pg8::gemm_phase<pg8::EpiScaleBf16, pg8::OneUnit, false, true>((LAS unsigned char*)lds, g, S1, E, tu);
                        asm volatile("s_waitcnt vmcnt(0)" ::: "memory");
                        __syncthreads();
                        if (tid == 0) { __builtin_amdgcn_fence(__ATOMIC_RELEASE, "agent"); asm volatile("s_waitcnt vmcnt(0)" ::: "memory");
                                        __hip_atomic_fetch_add(&w.ctr[256 + l * 4 + rep_i], 1u, __ATOMIC_RELAXED, __HIP_MEMORY_SCOPE_AGENT); }
                    } else {
                        const unsigned v = u - (unsigned)(T / 256);
                        if (v >= 256u + NB * NG && !dil_ready) {
                            if (tid == 0) { unsigned sp = 0; while (__hip_atomic_load(&w.ctr[256 + l * 4 + rep_i], __ATOMIC_RELAXED, __HIP_MEMORY_SCOPE_AGENT) < (unsigned)(T / 256)) { __builtin_amdgcn_s_sleep(4); if (++sp > (1u << 26)) break; }
                                            __builtin_amdgcn_fence(__ATOMIC_ACQUIRE, "agent"); asm volatile("s_waitcnt vmcnt(0)" ::: "memory"); }
                            __syncthreads();
                            dil_ready = true;
                        }
                        if (v >= 256u && v < 256u + NB * NG) s5_unit((LAS unsigned char*)lds, w, st, l, (int)(v - 256u) / NG, (int)(v - 256u) % NG, tu);
                        else attn_dispatch((LAS unsigned char*)lds, w, (v < 256u) ? (int)v : (int)v - NB * NG, ao, tu);
                    }
                }
            } else if (k == 2) {
                for (int u = bid; u < T / 64; u += G) b2_fast_unit((LAS unsigned char*)lds, w, l, ssm_g, dil_g, 64 * u, tid);
            } else if (k == 3) {
                pg8::Gemm g{w.cat, w.WoutT + (size_t)l * DM * DM, T, DM, DM}; pg8::StaticOrder S; S.init(T, DM, G, bid);
                pg8::EpiResid E{w.xb, w.xb1, w.ssqp};
                pg8::gemm_phase<pg8::EpiResid, pg8::StaticOrder, true, true>((LAS unsigned char*)lds, g, S, E, tid);
            } else if (k == 4) {
                pg8::Gemm g{w.xb1, w.WqT + (size_t)l * 2048 * DM, T, 2048, DM}; pg8::StaticOrder S; S.init(T, 2048, G, bid);
                pg8::EpiScaleQ E{w.q, w.ssqp};
                pg8::gemm_phase<pg8::EpiScaleQ, pg8::StaticOrder, true, true>((LAS unsigned char*)lds, g, S, E, tid);
#if PROBE_K != 5
                { const bf16_t* skg = w.SKb + ((size_t)l * PH + (bid & 7)) * 2 * PK * PHALF;
                  for (int i = tid; i < 256 * 16; i += NTHR) { const int row = i >> 4, pc = i & 15; *(LAS u32x4*)((LAS unsigned char*)lds + row * RT_SKP + pc * 16) = *(const u32x4*)(skg + (size_t)row * PHALF + pc * 8); } }
#endif
            } else if (k == 5) {
                const int h = bid & 7, nbh = G >> 3;
#if PROBE_K == 5
                { const bf16_t* skg = w.SKb + ((size_t)l * PH + h) * 2 * PK * PHALF;
                  for (int i = tid; i < 256 * 16; i += NTHR) { const int row = i >> 4, pc = i & 15; *(LAS u32x4*)((LAS unsigned char*)lds + row * RT_SKP + pc * 16) = *(const u32x4*)(skg + (size_t)row * PHALF + pc * 8); } }
#endif
                __syncthreads();
                volatile __attribute__((address_space(3))) unsigned* ldsw = (volatile __attribute__((address_space(3))) unsigned*)((LAS unsigned char*)lds + RT_SK_BYTES) + wv * (64 * 9);
                if ((G & 7) == 0) {
                    const int tb0 = (bid >> 3) + nbh * wv, tbs = nbh * NWAVE;
                    if (tb0 < T / 32) {
                        RouteQ qf; route_load_q(qf, w, tb0, h, lane & 31, lane >> 5);
                        for (int tb = tb0; tb < T / 32; tb += tbs) route_fast_unit(w, (const LAS unsigned char*)lds, qf, tb, (tb + tbs < T / 32) ? tb + tbs : -1, h, lane, ldsw);
                    }
                }
                __syncthreads();
            } else {
                peer_fast_wave(w, l, fin_g, (l == NL - 1) ? a.out : nullptr, gw, nw, lane);
            }
        }
        if (rep_i + 1 < reps) xcd_barrier(xbar);
      }
        if (ph + 1 < a.ph_hi) { if (a.ph_lo < 0) grid.sync(); else xcd_barrier(xbar); }
    }
}

#ifndef MK_ONE_LAUNCH
#define MK_ONE_LAUNCH 1
#endif
extern "C" void kernel_launch(void* const* d_in, const int* in_sizes, int n_in, void* d_out, int out_size, void* d_ws, size_t ws_size, hipStream_t stream) {
    static int grid = 0;
    if (grid == 0) {
        WS w; const size_t need = ws_carve((unsigned char*)d_ws, w);
        if (n_in != 26 || out_size != T * DM || ws_size < need) { fprintf(stderr, "kernel_launch: unexpected shapes (n_in %d out %d ws %zu need %zu)\n", n_in, out_size, ws_size, need); grid = -1; return; }
        int dev = 0, cus = 0, per_cu = 0;
        (void)hipGetDevice(&dev);
        (void)hipDeviceGetAttribute(&cus, hipDeviceAttributeMultiprocessorCount, dev);
        (void)hipFuncSetAttribute((const void*)mega, hipFuncAttributeMaxDynamicSharedMemorySize, LDS_BYTES);
        (void)hipOccupancyMaxActiveBlocksPerMultiprocessor(&per_cu, (const void*)mega, NTHR, LDS_BYTES);
        if (per_cu < 1) { fprintf(stderr, "kernel_launch: occupancy query says %d blocks/CU\n", per_cu); grid = -1; return; }
        grid = cus;
        fprintf(stderr, "kernel_launch: cus %d per_cu %d grid %d\n", cus, per_cu, grid);
    }
    if (grid < 0) return;
    { WS w; ws_carve((unsigned char*)d_ws, w);
      if (hipMemsetAsync(w.ctr, 0, 4096 + XCD_BAR_WORDS_C * 4, stream) != hipSuccess) { fprintf(stderr, "kernel_launch: memset of control words failed\n"); return; } }
    Args a{};
    for (int i = 0; i < 26; ++i) a.in[i] = (const float*)d_in[i];
    a.out = (float*)d_out; a.ws = (unsigned char*)d_ws;
#if MK_ONE_LAUNCH
    a.ph_lo = 0; a.ph_hi = N_PHASES;
    void* args[] = {&a};
    hipError_t e = hipLaunchCooperativeKernel((const void*)mega, dim3(grid), dim3(NTHR), args, LDS_BYTES, stream);
    if (e != hipSuccess) fprintf(stderr, "cooperative launch failed: %s (grid %d)\n", hipGetErrorString(e), grid);
#else
    for (int ph = 0; ph < N_PHASES; ++ph) { a.ph_lo = ph; a.ph_hi = ph + 1; hipLaunchKernelGGL(mega, dim3(grid), dim3(NTHR), LDS_BYTES, stream, a); }
#endif
}
```
